# Optimizing an MI355X kernel written in HIP

```python
import jax, jax.numpy as jnp
from jax import lax
import numpy as np

D_MODEL = 1024
BATCH = 8
SEQ = 2048
DEPTH = 1
DEC_BATCH = 32
DEC_SEQ = 1
PAST_LEN = 8192
PAGE_SIZE = 128

N_META = 16
SB_HEADS = 8
HEAD_DIM = 64
D_ATT = SB_HEADS * HEAD_DIM
D_CONV = D_MODEL // 2
CONV_K = 3
D_FF = -(-8 * D_MODEL // (3 * 256)) * 256
BLOCK = 128
EPS = 1e-6
SB_BIAS_HI = 5.0
SB_BIAS_LO = 9.0
SPLIT_SIZES = (D_ATT, D_ATT, D_ATT, D_CONV, D_CONV, D_CONV, D_MODEL, D_MODEL)
N_IN = sum(SPLIT_SIZES)

kernel_name = 'hybrid_stickbreak_shortconv_step'


def rms_norm(x, g):
    xf = x.astype(jnp.float32)
    y = xf * lax.rsqrt(jnp.mean(xf * xf, axis=-1, keepdims=True) + EPS)
    return (y * g.astype(jnp.float32)).astype(x.dtype)


def split_projection(h, w_in):
    b, t, _ = h.shape
    p = jnp.einsum('btd,dn->btn', h, w_in)
    cuts = [int(c) for c in np.cumsum(SPLIT_SIZES)[:-1]]
    q, k, v, b_gate, c_gate, x_conv, g_att, g_conv = jnp.split(p, cuts, axis=-1)
    heads = lambda a: a.reshape(b, t, SB_HEADS, HEAD_DIM)
    return heads(q), heads(k), heads(v), b_gate, c_gate, x_conv, g_att, g_conv


def stick_breaking(q, k, v, bias, q_pos, k_lo):
    L = k.shape[1]
    z = jnp.einsum('bqhd,bkhd->bhqk', q.astype(jnp.float32), k.astype(jnp.float32)) * (HEAD_DIM ** -0.5)
    z = z + bias.astype(jnp.float32)[None, :, None, None]
    s_idx = jnp.arange(L)
    mask = (s_idx[None, :] < q_pos[:, None]) & (s_idx[None, :] >= k_lo)
    log_beta = jax.nn.log_sigmoid(z)
    log_1m = jnp.where(mask, jax.nn.log_sigmoid(-z), 0.0)
    suffix = lax.cumsum(log_1m, axis=3, reverse=True) - log_1m
    w = jnp.where(mask, jnp.exp(log_beta + suffix), 0.0)
    return jnp.einsum('bhqk,bkhd->bqhd', w, v.astype(jnp.float32))


def prompt_stick_breaking(q, k, v, bias):
    b, t, h, d = q.shape
    pad = (-N_META) % BLOCK
    pw = ((0, 0), (pad, 0), (0, 0), (0, 0))
    qp, kp, vp = jnp.pad(q, pw), jnp.pad(k, pw), jnp.pad(v, pw)
    L = t + pad
    n_blocks = L // BLOCK

    def one_block(i):
        qb = lax.dynamic_slice_in_dim(qp, i * BLOCK, BLOCK, axis=1)
        q_pos = i * BLOCK + jnp.arange(BLOCK)
        return stick_breaking(qb, kp, vp, bias, q_pos, pad)

    o = lax.map(one_block, jnp.arange(n_blocks))
    o = jnp.moveaxis(o, 0, 1).reshape(b, L, h, d)
    return o[:, pad:]


def short_conv(u_ext, w, t):
    return sum(w[i] * u_ext[:, i:i + t] for i in range(CONV_K))


def gated_merge(o_att, y_conv, g_att, g_conv, w_att_out, w_conv_out, w_o):
    b, t, _ = y_conv.shape
    dt = y_conv.dtype
    y_a = jnp.einsum('bte,ed->btd', o_att.reshape(b, t, D_ATT).astype(dt), w_att_out)
    y_b = jnp.einsum('bte,ed->btd', y_conv, w_conv_out)
    m = jax.nn.sigmoid(g_att) * y_a + jax.nn.sigmoid(g_conv) * y_b
    return jnp.einsum('btd,de->bte', m, w_o)


def swiglu(h, w_gate, w_up, w_down):
    a = jax.nn.silu(jnp.einsum('btd,df->btf', h, w_gate)) * jnp.einsum('btd,df->btf', h, w_up)
    return jnp.einsum('btf,fd->btd', a, w_down)


def setup_inputs(seed: int = 0) -> dict:
    key = jax.random.key(seed)
    ks = jax.random.split(key, 20)
    nrm = lambda k, shape, scale: jax.random.normal(k, shape, jnp.float32) * scale
    n_pages = PAST_LEN // PAGE_SIZE
    used = DEC_BATCH * n_pages
    n_phys = used + max(1, used // 4)
    page_table = jax.random.permutation(ks[5], n_phys)[:used].reshape(DEC_BATCH, n_pages).astype(jnp.int32)
    sb_bias = (-jnp.linspace(SB_BIAS_HI, SB_BIAS_LO, SB_HEADS, dtype=jnp.float32)[None, :]
               + nrm(ks[18], (DEPTH, SB_HEADS), 0.1))
    return {
        'x_prompt': nrm(ks[0], (BATCH, SEQ, D_MODEL), 1.0),
        'x_sample': nrm(ks[1], (DEC_BATCH, DEC_SEQ, D_MODEL), 1.0),
        'cache_k': nrm(ks[2], (DEPTH, n_phys, PAGE_SIZE, SB_HEADS, HEAD_DIM), 1.0),
        'cache_v': nrm(ks[3], (DEPTH, n_phys, PAGE_SIZE, SB_HEADS, HEAD_DIM), 1.0),
        'state_conv': nrm(ks[4], (DEPTH, DEC_BATCH, CONV_K - 1, D_CONV), 1.0),
        'page_table': page_table,
        'meta_tokens': nrm(ks[6], (N_META, D_MODEL), 1.0),
        'norm_mix': 1.0 + nrm(ks[7], (DEPTH, D_MODEL), 0.05),
        'w_in': nrm(ks[8], (DEPTH, D_MODEL, N_IN), D_MODEL ** -0.5),
        'sb_bias': sb_bias,
        'conv_w': nrm(ks[9], (DEPTH, CONV_K, D_CONV), CONV_K ** -0.5),
        'w_att_out': nrm(ks[10], (DEPTH, D_ATT, D_MODEL), D_ATT ** -0.5),
        'w_conv_out': nrm(ks[11], (DEPTH, D_CONV, D_MODEL), D_CONV ** -0.5),
        'w_o': nrm(ks[12], (DEPTH, D_MODEL, D_MODEL), D_MODEL ** -0.5),
        'norm_ffn': 1.0 + nrm(ks[13], (DEPTH, D_MODEL), 0.05),
        'w_gate': nrm(ks[14], (DEPTH, D_MODEL, D_FF), D_MODEL ** -0.5),
        'w_up': nrm(ks[15], (DEPTH, D_MODEL, D_FF), D_MODEL ** -0.5),
        'w_down': nrm(ks[16], (DEPTH, D_FF, D_MODEL), D_FF ** -0.5),
        'norm_final': 1.0 + nrm(ks[17], (D_MODEL,), 0.05),
    }


def reference(x_prompt, x_sample, cache_k, cache_v, state_conv, page_table, meta_tokens,
              norm_mix, w_in, sb_bias, conv_w, w_att_out, w_conv_out, w_o, norm_ffn,
              w_gate, w_up, w_down, norm_final):
    n_prompt = x_prompt.shape[0]
    n_dec, t_dec = x_sample.shape[0], x_sample.shape[1]
    meta = jnp.broadcast_to(meta_tokens[None].astype(x_prompt.dtype), (n_prompt, N_META, D_MODEL))
    xp = jnp.concatenate([meta, x_prompt], axis=1)
    xs = x_sample
    kp_l, vp_l, cp_l, ks_l, vs_l, cs_l = [], [], [], [], [], []
    for l in range(DEPTH):
        h = rms_norm(xp, norm_mix[l])
        q, k, v, bg, cg, xc, ga, gb = split_projection(h, w_in[l])
        o_att = prompt_stick_breaking(q, k, v, sb_bias[l])
        u = cg * xc
        u_ext = jnp.concatenate([jnp.zeros((n_prompt, CONV_K - 1, D_CONV), u.dtype), u], axis=1)
        y_conv = bg * short_conv(u_ext, conv_w[l], u.shape[1])
        xp = xp + gated_merge(o_att, y_conv, ga, gb, w_att_out[l], w_conv_out[l], w_o[l])
        xp = xp + swiglu(rms_norm(xp, norm_ffn[l]), w_gate[l], w_up[l], w_down[l])
        kp_l.append(k)
        vp_l.append(v)
        cp_l.append(u_ext[:, -(CONV_K - 1):])
        h = rms_norm(xs, norm_mix[l])
        q, k, v, bg, cg, xc, ga, gb = split_projection(h, w_in[l])
        k_past = cache_k[l][page_table].reshape(n_dec, -1, SB_HEADS, HEAD_DIM)
        v_past = cache_v[l][page_table].reshape(n_dec, -1, SB_HEADS, HEAD_DIM)
        past = k_past.shape[1]
        k_all = jnp.concatenate([k_past.astype(k.dtype), k], axis=1)
        v_all = jnp.concatenate([v_past.astype(v.dtype), v], axis=1)
        o_att = stick_breaking(q, k_all, v_all, sb_bias[l], past + jnp.arange(t_dec), 0)
        u = cg * xc
        u_ext = jnp.concatenate([state_conv[l].astype(u.dtype), u], axis=1)
        y_conv = bg * short_conv(u_ext, conv_w[l], t_dec)
        xs = xs + gated_merge(o_att, y_conv, ga, gb, w_att_out[l], w_conv_out[l], w_o[l])
        xs = xs + swiglu(rms_norm(xs, norm_ffn[l]), w_gate[l], w_up[l], w_down[l])
        ks_l.append(k)
        vs_l.append(v)
        cs_l.append(u_ext[:, -(CONV_K - 1):])
    y_prompt = rms_norm(xp, norm_final)[:, N_META:]
    y_sample = rms_norm(xs, norm_final)
    return (y_prompt, y_sample, jnp.stack(kp_l), jnp.stack(vp_l), jnp.stack(cp_l),
            jnp.stack(ks_l), jnp.stack(vs_l), jnp.stack(cs_l))
```

```cpp
#include <hip/hip_runtime.h>
#include <hip/hip_bf16.h>
#include <cstdio>
#include <cstdint>
#include <type_traits>
__device__ __forceinline__ int tid_now() { int t = threadIdx.x; asm volatile("" : "+v"(t)); return t; }

constexpr int D = 1024, NBATCH = 8, TSEQ = 2048, NMETA = 16, NSAMP = 32, NHEAD = 8, HDIM = 64, DATT = 512, DCONV = 512, FF = 2816;
constexpr int MMAIN = NBATCH * TSEQ;
constexpr int ROW_META = MMAIN;
constexpr int ROW_SAMP = MMAIN + NMETA;
constexpr int ROW_END = ROW_SAMP + NSAMP;
constexpr int M_TOT = 16640;
constexpr int NIN = 5120, NGU = 2 * FF;
constexpr int KPAD = 2112;
constexpr int LSEQ = NMETA + TSEQ;
constexpr int PAST = 8192, PAGE = 128, NPAGES = 64;
constexpr float EPS = 1e-6f;
constexpr float LOG2E = 1.4426950408889634f;
constexpr float C2 = 0.125f * LOG2E;
constexpr size_t OFF_Y = 0, OFF_YS = 16777216, OFF_KP = 16809984, OFF_VP = 25264128, OFF_CP = 33718272, OFF_KS = 33726464, OFF_VS = 33742848, OFF_CS = 33759232, OUT_TOTAL = 33792000;

namespace pg8 {
#define PG8_LAS __attribute__((address_space(3)))
typedef unsigned short bf16_t;
typedef short bf16x8 __attribute__((ext_vector_type(8)));
typedef float f32x4 __attribute__((ext_vector_type(4)));
typedef unsigned u32x4 __attribute__((ext_vector_type(4)));
constexpr int BM = 256, BK = 64, HALF = 128, HTB = HALF * BK * 2  , STAGE_BYTES = 8 * HTB, NXCD = 8, WGM = 8;

__host__ __device__ __forceinline__ int lds_byte(int r, int c) { const int st = (r >> 4) * 2 + (c >> 5), rr = r & 15, cc = c & 31, ob = rr * 64 + cc * 2; return st * 1024 + (ob ^ (((ob >> 9) & 1) << 5)); }
__host__ __device__ __forceinline__ void stage_rc(int b, int& R, int& C) { const int st = b / 1024, sb = b % 1024, swz = sb ^ (((sb >> 9) & 1) << 5); R = (st >> 1) * 16 + swz / 64; C = (st & 1) * 32 + (swz % 64) / 2; }
__host__ __device__ __forceinline__ int perm32(int rho) { const int n = rho >> 4, i = rho & 15; return 8 * (i >> 2) + 4 * n + (i & 3); }

struct Unit { int pm, pn; };
struct Gemm { const bf16_t* A; const bf16_t* Bt; int M, N, K; };

struct StaticOrder {
    int nM, nN, nwg, G, c;
    __host__ __device__ void init(int M, int N, int G_, int c_) { nM = M / BM; nN = N / BM; nwg = nM * nN; G = G_; c = c_; }
    __host__ __device__ bool next(int i, Unit& u) const {
        const long L = (long)i * G + c; if (L >= nwg) return false;
        int wgid = (int)L; { const int q = nwg / NXCD, r = nwg % NXCD, xcd = wgid % NXCD, off = wgid / NXCD; wgid = (xcd < r ? xcd * (q + 1) : r * (q + 1) + (xcd - r) * q) + off; }
        const int nig = WGM * nN, gid = wgid / nig, fm = gid * WGM, gsz = (nM - fm) < WGM ? (nM - fm) : WGM;
        u.pm = fm + ((wgid % nig) % gsz); u.pn = (wgid % nig) / gsz; return true;
    }
    __device__ __forceinline__ void a_ready(const Unit&) const {}
    __device__ __forceinline__ void done(const Unit&) const {}
};

__device__ __forceinline__ unsigned cvt_pk_bf16(float lo, float hi) { unsigned r; asm volatile("v_cvt_pk_bf16_f32 %0, %1, %2" : "=v"(r) : "v"(lo), "v"(hi)); return r; }
typedef float f32x2 __attribute__((ext_vector_type(2)));
__device__ __forceinline__ u32x4 pack8(const f32x4 a, const f32x4 b) { u32x4 w; w.x = cvt_pk_bf16(a[0], a[1]); w.y = cvt_pk_bf16(a[2], a[3]); w.z = cvt_pk_bf16(b[0], b[1]); w.w = cvt_pk_bf16(b[2], b[3]); return w; }
__device__ __forceinline__ float bf_lo(unsigned w) { return __builtin_bit_cast(float, w << 16); }
__device__ __forceinline__ float bf_hi(unsigned w) { return __builtin_bit_cast(float, w & 0xffff0000u); }
__device__ __forceinline__ void unpack8(const u32x4 w, f32x4& a, f32x4& b) { a = (f32x4){bf_lo(w.x), bf_hi(w.x), bf_lo(w.y), bf_hi(w.y)}; b = (f32x4){bf_lo(w.z), bf_hi(w.z), bf_lo(w.w), bf_hi(w.w)}; }

struct Epi1 {
    static constexpr bool PERM = true, AFTER_DRAIN = false, HAS_MID = false;
    bf16_t *Qb, *Kb, *Vb, *BG, *U, *G; float* out;
    __device__ __forceinline__ void mid(f32x4 (&acc)[2][2][4][2], const Unit& u, int wr, int wc, int fr, int fq) const {}
    __device__ __forceinline__ void operator()(const f32x4 (&acc)[2][2][4][2], const Unit& u, int wr, int wc, int fr, int fq) const {
        const int pn = u.pn, cc = wc * 32 + 8 * fq;
#pragma unroll
        for (int ai = 0; ai < 2; ++ai)
#pragma unroll
            for (int m = 0; m < 4; ++m) {
                const int row = u.pm * BM + ai * HALF + wr * 64 + m * 16 + fr;
                if (pn < 2) {
#pragma unroll
                    for (int bj = 0; bj < 2; ++bj) *(u32x4*)(Qb + (size_t)row * DATT + pn * 256 + bj * HALF + cc) = pack8(acc[ai][bj][m][0] * C2, acc[ai][bj][m][1] * C2);
                } else if (pn < 6) {
                    const bool isv = pn >= 4; bf16_t* KV = isv ? Vb : Kb; float* outp = out + (isv ? OFF_VP : OFF_KP); float* outs = out + (isv ? OFF_VS : OFF_KS);
#pragma unroll
                    for (int bj = 0; bj < 2; ++bj) { const int col = (pn & 1) * 256 + bj * HALF + cc; const f32x4 v0 = acc[ai][bj][m][0], v1 = acc[ai][bj][m][1]; const u32x4 w = pack8(v0, v1);
                        if (row < MMAIN) { const int b = row >> 11, t = row & 2047; *(u32x4*)(KV + (size_t)(b * KPAD + 64 + t) * DATT + col) = w;
                            float* o = outp + (size_t)(b * LSEQ + NMETA + t) * DATT + col; *(f32x4*)o = v0; *(f32x4*)(o + 4) = v1; }
                        else if (row < ROW_SAMP) { const int i = row - ROW_META;
                            for (int b = 0; b < NBATCH; ++b) { *(u32x4*)(KV + (size_t)(b * KPAD + 48 + i) * DATT + col) = w; float* o = outp + (size_t)(b * LSEQ + i) * DATT + col; *(f32x4*)o = v0; *(f32x4*)(o + 4) = v1; } }
                        else if (row < ROW_END) { float* o = outs + (size_t)(row - ROW_SAMP) * DATT + col; *(f32x4*)o = v0; *(f32x4*)(o + 4) = v1; } }
                } else if (pn < 8) {
#pragma unroll
                    for (int bj = 0; bj < 2; ++bj) *(u32x4*)(BG + (size_t)row * DCONV + (pn - 6) * 256 + bj * HALF + cc) = pack8(acc[ai][bj][m][0], acc[ai][bj][m][1]);
                } else if (pn < 12) {
                    const int ch = (pn - 8) * HALF + cc; const f32x4 u0 = acc[ai][0][m][0] * acc[ai][1][m][0], u1 = acc[ai][0][m][1] * acc[ai][1][m][1];
                    *(u32x4*)(U + (size_t)row * DCONV + ch) = pack8(u0, u1);
                    if (row < MMAIN) { const int t = row & 2047; if (t >= TSEQ - 2) { float* o = out + OFF_CP + (size_t)((row >> 11) * 2 + (t - (TSEQ - 2))) * DCONV + ch; *(f32x4*)o = u0; *(f32x4*)(o + 4) = u1; } }
                    else if (row >= ROW_SAMP && row < ROW_END) { float* o = out + OFF_CS + (size_t)((row - ROW_SAMP) * 2 + 1) * DCONV + ch; *(f32x4*)o = u0; *(f32x4*)(o + 4) = u1; }
                } else {
                    const int ch = (pn - 12) * HALF + cc; f32x4 r[2], s[2];
#pragma unroll
                    for (int n = 0; n < 2; ++n)
#pragma unroll
                        for (int e = 0; e < 4; ++e) { const float ga = fminf(fmaxf(acc[ai][0][m][n][e], -30.f), 30.f), gb = fminf(fmaxf(acc[ai][1][m][n][e], -30.f), 30.f);
                            const float ea = __builtin_amdgcn_exp2f(-ga * LOG2E), eb = __builtin_amdgcn_exp2f(-gb * LOG2E); const float ia = __builtin_amdgcn_rcpf(1.f + ea), ib = __builtin_amdgcn_rcpf(1.f + eb);
                            r[n][e] = (1.f + eb) * ia; s[n][e] = ib; }
                    *(u32x4*)(G + (size_t)row * 2048 + ch) = pack8(r[0], r[1]); *(u32x4*)(G + (size_t)row * 2048 + 1024 + ch) = pack8(s[0], s[1]);
                }
            }
    }
};
struct Epi3 {
    static constexpr bool PERM = true, AFTER_DRAIN = false, HAS_MID = true;
    const bf16_t* G; bf16_t* Mb;
    __device__ __forceinline__ void mid(f32x4 (&acc)[2][2][4][2], const Unit& u, int wr, int wc, int fr, int fq) const {
#pragma unroll
        for (int ai = 0; ai < 2; ++ai)
#pragma unroll
            for (int m = 0; m < 4; ++m) { const int row = u.pm * BM + ai * HALF + wr * 64 + m * 16 + fr;
#pragma unroll
                for (int bj = 0; bj < 2; ++bj) { const int col = u.pn * BM + bj * HALF + wc * 32 + 8 * fq; f32x4 a, b; unpack8(*(const u32x4*)(G + (size_t)row * 2048 + col), a, b);
                    acc[ai][bj][m][0] *= a; acc[ai][bj][m][1] *= b; } }
    }
    __device__ __forceinline__ void operator()(const f32x4 (&acc)[2][2][4][2], const Unit& u, int wr, int wc, int fr, int fq) const {
#pragma unroll
        for (int ai = 0; ai < 2; ++ai)
#pragma unroll
            for (int m = 0; m < 4; ++m) { const int row = u.pm * BM + ai * HALF + wr * 64 + m * 16 + fr;
#pragma unroll
                for (int bj = 0; bj < 2; ++bj) { const int col = u.pn * BM + bj * HALF + wc * 32 + 8 * fq; f32x4 a, b; unpack8(*(const u32x4*)(G + (size_t)row * 2048 + 1024 + col), a, b);
                    *(u32x4*)(Mb + (size_t)row * D + col) = pack8(acc[ai][bj][m][0] * a, acc[ai][bj][m][1] * b); } }
    }
};
struct RowMap {
    const float *xp, *xs, *meta; float *y, *x1s;
    __device__ __forceinline__ const float* xin(int row) const { return row < MMAIN ? xp + (size_t)row * D : row < ROW_SAMP ? meta + (size_t)(row - ROW_META) * D : row < ROW_END ? xs + (size_t)(row - ROW_SAMP) * D : nullptr; }
    __device__ __forceinline__ float* x1(int row) const { return row < MMAIN ? y + (size_t)row * D : x1s + (size_t)(row - MMAIN) * D; }
};
struct Epi4 {
    static constexpr bool PERM = true, AFTER_DRAIN = false, HAS_MID = false;
    RowMap R; bf16_t* X1b; float* rowsum;
    __device__ __forceinline__ void mid(f32x4 (&acc)[2][2][4][2], const Unit& u, int wr, int wc, int fr, int fq) const {}
    __device__ __forceinline__ void operator()(const f32x4 (&acc)[2][2][4][2], const Unit& u, int wr, int wc, int fr, int fq) const {
#pragma unroll
        for (int ai = 0; ai < 2; ++ai)
#pragma unroll
            for (int m = 0; m < 4; ++m) { const int row = u.pm * BM + ai * HALF + wr * 64 + m * 16 + fr; const float* xi = R.xp + (size_t)row * D; float ss = 0.f;
#pragma unroll
                for (int bj = 0; bj < 2; ++bj) { const int col = u.pn * BM + bj * HALF + wc * 32 + 8 * fq;
                    f32x4 a = *(const f32x4*)(xi + col), b = *(const f32x4*)(xi + col + 4);
                    a += acc[ai][bj][m][0]; b += acc[ai][bj][m][1];
                    *(u32x4*)(X1b + (size_t)row * D + col) = pack8(a, b);
                    ss += (a[0] * a[0] + a[1] * a[1]) + (a[2] * a[2] + a[3] * a[3]) + (b[0] * b[0] + b[1] * b[1]) + (b[2] * b[2] + b[3] * b[3]); }
                ss += __shfl_xor(ss, 16); ss += __shfl_xor(ss, 32);
                if (fq == 0) unsafeAtomicAdd(rowsum + row, ss); }
    }
};
struct Epi5 {
    static constexpr bool PERM = true, AFTER_DRAIN = false, HAS_MID = false;
    const float* rowsum; bf16_t* ACT;
    __device__ __forceinline__ void mid(f32x4 (&acc)[2][2][4][2], const Unit& u, int wr, int wc, int fr, int fq) const {}
    __device__ __forceinline__ void operator()(const f32x4 (&acc)[2][2][4][2], const Unit& u, int wr, int wc, int fr, int fq) const {
#pragma unroll
        for (int ai = 0; ai < 2; ++ai)
#pragma unroll
            for (int m = 0; m < 4; ++m) { const int row = u.pm * BM + ai * HALF + wr * 64 + m * 16 + fr; const float rstd = __builtin_amdgcn_rsqf(rowsum[row] * (1.0f / D) + EPS); f32x4 o[2];
#pragma unroll
                for (int n = 0; n < 2; ++n)
#pragma unroll
                    for (int e = 0; e < 4; ++e) { const float g = acc[ai][0][m][n][e] * rstd, up = acc[ai][1][m][n][e] * rstd; const float eg = __builtin_amdgcn_exp2f(-g * LOG2E);
                        o[n][e] = g * __builtin_amdgcn_rcpf(1.f + eg) * up; }
                *(u32x4*)(ACT + (size_t)row * FF + u.pn * HALF + wc * 32 + 8 * fq) = pack8(o[0], o[1]); }
    }
};
struct Epi6 {
    static constexpr bool PERM = true, AFTER_DRAIN = false, HAS_MID = false;
    const bf16_t* X1b; bf16_t* X2b; float* rowsum;
    __device__ __forceinline__ void mid(f32x4 (&acc)[2][2][4][2], const Unit& u, int wr, int wc, int fr, int fq) const {}
    __device__ __forceinline__ void operator()(const f32x4 (&acc)[2][2][4][2], const Unit& u, int wr, int wc, int fr, int fq) const {
#pragma unroll
        for (int ai = 0; ai < 2; ++ai)
#pragma unroll
            for (int m = 0; m < 4; ++m) { const int row = u.pm * BM + ai * HALF + wr * 64 + m * 16 + fr; float ss = 0.f;
#pragma unroll
                for (int bj = 0; bj < 2; ++bj) { const int col = u.pn * BM + bj * HALF + wc * 32 + 8 * fq;
                    f32x4 a, b; unpack8(*(const u32x4*)(X1b + (size_t)row * D + col), a, b);
                    a += acc[ai][bj][m][0]; b += acc[ai][bj][m][1];
                    *(u32x4*)(X2b + (size_t)row * D + col) = pack8(a, b);
                    ss += (a[0] * a[0] + a[1] * a[1]) + (a[2] * a[2] + a[3] * a[3]) + (b[0] * b[0] + b[1] * b[1]) + (b[2] * b[2] + b[3] * b[3]); }
                ss += __shfl_xor(ss, 16); ss += __shfl_xor(ss, 32);
                if (fq == 0) unsafeAtomicAdd(rowsum + row, ss); }
    }
};

template <class Epi, class Sched, bool ALIGN_EPI = false, bool SP2 = false>
__device__ __forceinline__ void gemm_phase(PG8_LAS unsigned char* lds, const Gemm g, const Sched& S, const Epi& E) {
    const int tid = tid_now(), wid = __builtin_amdgcn_readfirstlane(tid >> 6), lane = tid & 63, wr = wid >> 2, wc = wid & 3, fr = lane & 15, fq = lane >> 4;
    const int K = g.K, nt = K / BK;
    unsigned voffA[2], voffB[2];
#pragma unroll
    for (int i = 0; i < 2; ++i) { int R, C; stage_rc(tid * 16 + i * 8192, R, C); const int Rb = Epi::PERM ? ((R & ~31) + perm32(R & 31)) : R;
        voffA[i] = (unsigned)(R * K + C) * 2u; voffB[i] = (unsigned)(Rb * K + C) * 2u; }
    const size_t kstep = (size_t)(BK * 2);
    const size_t hstep = (size_t)HALF * K * 2;
    const size_t tstep = 2 * hstep;
    const unsigned ldsw = (unsigned)wid * 1024u;
    const int aoff = lds_byte(wr * 64 + fr, fq * 8), boff = lds_byte(wc * 32 + fr, fq * 8);
#define PG8_SA(b, h) (((b) * 2 + (h)) * HTB)
#define PG8_SB(b, h) ((4 + (b) * 2 + (h)) * HTB)
#define PG8_STAGE(bufoff, gbase, voff) do { _Pragma("unroll") for (int _i = 0; _i < 2; ++_i) \
        __builtin_amdgcn_global_load_lds((const unsigned*)((const char*)(gbase) + (voff)[_i]), (PG8_LAS unsigned*)(lds + (bufoff) + ldsw + _i * 8192), 16, 0, 0); } while (0)
#define PG8_LDA(dst, b, h) do { _Pragma("unroll") for (int m = 0; m < 4; ++m) _Pragma("unroll") for (int k = 0; k < 2; ++k) dst[m][k] = *(const PG8_LAS bf16x8*)(lds + PG8_SA(b, h) + aoff + m * 2048 + k * 1024); } while (0)
#define PG8_LDB(dst, b, h) do { _Pragma("unroll") for (int n = 0; n < 2; ++n) _Pragma("unroll") for (int k = 0; k < 2; ++k) dst[n][k] = *(const PG8_LAS bf16x8*)(lds + PG8_SB(b, h) + boff + n * 2048 + k * 1024); } while (0)
#define PG8_MMA(ai, bj, At, Bt) do { __builtin_amdgcn_s_setprio(1); _Pragma("unroll") for (int m = 0; m < 4; ++m) _Pragma("unroll") for (int n = 0; n < 2; ++n) _Pragma("unroll") for (int k = 0; k < 2; ++k) \
        acc[ai][bj][m][n] = __builtin_amdgcn_mfma_f32_16x16x32_bf16(Bt[n][k], At[m][k], acc[ai][bj][m][n], 0, 0, 0); __builtin_amdgcn_s_setprio(0); } while (0)
#define PG8_WAIT_V(n) asm volatile("s_waitcnt vmcnt(" #n ")" ::: "memory")
#define PG8_WAIT_L(n) asm volatile("s_waitcnt lgkmcnt(" #n ")" ::: "memory")
#define PG8_BAR __builtin_amdgcn_s_barrier()
#define PG8_SCHED __builtin_amdgcn_sched_barrier(0)
    Unit cur, nxt; int ui = 0;
    if (!S.next(0, cur)) return;
    f32x4 acc[2][2][4][2];
#pragma unroll
    for (int a = 0; a < 2; ++a)
#pragma unroll
        for (int b = 0; b < 2; ++b)
#pragma unroll
            for (int m = 0; m < 4; ++m)
#pragma unroll
                for (int n = 0; n < 2; ++n) acc[a][b][m][n] = (f32x4){0.f, 0.f, 0.f, 0.f};
    bf16x8 At[4][2], B0[2][2], B1[2][2];
    const char* cA = (const char*)g.A + (size_t)cur.pm * tstep; const char* cB = (const char*)g.Bt + (size_t)cur.pn * tstep;
    S.a_ready(cur);
    if constexpr (SP2) {
        PG8_STAGE(PG8_SB(0, 0), cB, voffB); PG8_STAGE(PG8_SB(0, 1), cB + hstep, voffB); PG8_STAGE(PG8_SA(0, 0), cA, voffA); PG8_STAGE(PG8_SA(0, 1), cA + hstep, voffA);
        if (wr == 1) PG8_BAR;
        PG8_WAIT_V(2); PG8_BAR;
        PG8_STAGE(PG8_SB(1, 0), cB + kstep, voffB); PG8_STAGE(PG8_SA(1, 0), cA + kstep, voffA); PG8_STAGE(PG8_SB(1, 1), cB + hstep + kstep, voffB);
        PG8_WAIT_V(6); PG8_BAR;
    } else {
        PG8_STAGE(PG8_SB(0, 0), cB, voffB); PG8_STAGE(PG8_SA(0, 0), cA, voffA); PG8_STAGE(PG8_SB(0, 1), cB + hstep, voffB); PG8_STAGE(PG8_SA(0, 1), cA + hstep, voffA);
        if (wr == 1) PG8_BAR;
        PG8_WAIT_V(4); PG8_BAR;
        PG8_STAGE(PG8_SB(1, 0), cB + kstep, voffB); PG8_STAGE(PG8_SA(1, 0), cA + kstep, voffA); PG8_STAGE(PG8_SB(1, 1), cB + hstep + kstep, voffB);
        PG8_WAIT_V(6); PG8_BAR;
    }
    for (;;) {
        const bool has_next = S.next(ui + 1, nxt);
        const char* nA = has_next ? (const char*)g.A + (size_t)nxt.pm * tstep : cA; const char* nB = has_next ? (const char*)g.Bt + (size_t)nxt.pn * tstep : cB;
        for (int t = 0; t < nt; t += 2) {
            if constexpr (Epi::HAS_MID) { if (t == (nt >> 1)) E.mid(acc, cur, wr, wc, fr, fq); }
            const bool last = (t == nt - 2);
            const char* a1 = cA + (size_t)(t + 1) * kstep;
            const char* a2 = last ? nA : cA + (size_t)(t + 2) * kstep; const char* b2 = last ? nB : cB + (size_t)(t + 2) * kstep;
            const char* a3 = a2 + kstep; const char* b3 = b2 + kstep;
            if (last && has_next) S.a_ready(nxt);
            if constexpr (SP2) {
            PG8_LDB(B0, 0, 0); PG8_LDB(B1, 0, 1); PG8_SCHED; PG8_LDA(At, 0, 0); PG8_STAGE(PG8_SA(1, 1), a1 + hstep, voffA);
            PG8_WAIT_V(8); PG8_WAIT_L(0); PG8_BAR; PG8_MMA(0, 0, At, B0); PG8_MMA(0, 1, At, B1); PG8_BAR; PG8_SCHED;
            PG8_LDA(At, 0, 1); PG8_STAGE(PG8_SB(0, 0), b2, voffB); PG8_STAGE(PG8_SB(0, 1), b2 + hstep, voffB); PG8_STAGE(PG8_SA(0, 0), a2, voffA);
            PG8_WAIT_V(8); PG8_WAIT_L(0); PG8_BAR; PG8_MMA(1, 0, At, B0); PG8_MMA(1, 1, At, B1); PG8_BAR; PG8_SCHED;
            PG8_LDB(B0, 1, 0); PG8_LDB(B1, 1, 1); PG8_SCHED; PG8_LDA(At, 1, 0); PG8_STAGE(PG8_SA(0, 1), a2 + hstep, voffA);
            PG8_WAIT_V(8); PG8_WAIT_L(0); PG8_BAR; PG8_MMA(0, 0, At, B0); PG8_MMA(0, 1, At, B1); PG8_BAR; PG8_SCHED;
            PG8_LDA(At, 1, 1); PG8_STAGE(PG8_SB(1, 0), b3, voffB); PG8_STAGE(PG8_SB(1, 1), b3 + hstep, voffB); PG8_STAGE(PG8_SA(1, 0), a3, voffA);
            PG8_WAIT_V(8); PG8_WAIT_L(0); PG8_BAR; PG8_MMA(1, 0, At, B0); PG8_MMA(1, 1, At, B1); PG8_BAR; PG8_SCHED;
            } else {
            PG8_LDB(B0, 0, 0); PG8_SCHED; PG8_LDA(At, 0, 0); PG8_STAGE(PG8_SA(1, 1), a1 + hstep, voffA);
            PG8_WAIT_L(8); PG8_BAR; PG8_WAIT_L(0); PG8_MMA(0, 0, At, B0); PG8_BAR; PG8_SCHED;
            PG8_LDB(B1, 0, 1); PG8_STAGE(PG8_SB(0, 0), b2, voffB);
            PG8_BAR; PG8_WAIT_L(0); PG8_MMA(0, 1, At, B1); PG8_BAR;
            PG8_LDA(At, 0, 1); PG8_STAGE(PG8_SA(0, 0), a2, voffA);
            PG8_BAR; PG8_WAIT_L(0); PG8_MMA(1, 0, At, B0); PG8_BAR; PG8_SCHED;
            PG8_STAGE(PG8_SB(0, 1), b2 + hstep, voffB);
            PG8_WAIT_V(6); PG8_BAR; PG8_MMA(1, 1, At, B1); PG8_BAR;
            PG8_LDB(B0, 1, 0); PG8_SCHED; PG8_LDA(At, 1, 0); PG8_STAGE(PG8_SA(0, 1), a2 + hstep, voffA);
            PG8_WAIT_L(8); PG8_BAR; PG8_WAIT_L(0); PG8_MMA(0, 0, At, B0); PG8_BAR; PG8_SCHED;
            PG8_LDB(B1, 1, 1); PG8_STAGE(PG8_SB(1, 0), b3, voffB);
            PG8_BAR; PG8_WAIT_L(0); PG8_MMA(0, 1, At, B1); PG8_BAR;
            PG8_LDA(At, 1, 1); PG8_STAGE(PG8_SA(1, 0), a3, voffA);
            PG8_BAR; PG8_WAIT_L(0); PG8_MMA(1, 0, At, B0); PG8_BAR; PG8_SCHED;
            PG8_STAGE(PG8_SB(1, 1), b3 + hstep, voffB);
            PG8_WAIT_V(6); PG8_BAR; PG8_MMA(1, 1, At, B1); PG8_BAR;
            }
        }
        if constexpr (ALIGN_EPI) { if (wr == 0) PG8_BAR; }
        if constexpr (!Epi::AFTER_DRAIN) { E(acc, cur, wr, wc, fr, fq); S.done(cur); }
        if (!has_next) break;
#pragma unroll
        for (int a = 0; a < 2; ++a)
#pragma unroll
            for (int b = 0; b < 2; ++b)
#pragma unroll
                for (int m = 0; m < 4; ++m)
#pragma unroll
                    for (int n = 0; n < 2; ++n) acc[a][b][m][n] = (f32x4){0.f, 0.f, 0.f, 0.f};
        cur = nxt; cA = nA; cB = nB; ++ui;
        if constexpr (ALIGN_EPI) { if (wr == 1) PG8_BAR; }
    }
    PG8_WAIT_V(0);
    if constexpr (!ALIGN_EPI) { if (wr == 0) PG8_BAR; }
    PG8_BAR;
    if constexpr (Epi::AFTER_DRAIN) { E.fused(acc, cur, wr, wc, fr, fq, lds, wid, lane); S.done(cur); }
#undef PG8_SA
#undef PG8_SB
#undef PG8_STAGE
#undef PG8_LDA
#undef PG8_LDB
#undef PG8_MMA
#undef PG8_WAIT_V
#undef PG8_WAIT_L
#undef PG8_BAR
#undef PG8_SCHED
}
}

namespace sbattn {
using bf16x8 = __attribute__((ext_vector_type(8))) short;
using s16x4 = __attribute__((ext_vector_type(4))) short;
using f32x16 = __attribute__((ext_vector_type(16))) float;
using u32x4 = __attribute__((ext_vector_type(4))) unsigned;
typedef _Float16 f16x8 __attribute__((ext_vector_type(8)));
typedef __attribute__((address_space(3))) const char* lds_cptr;
constexpr int SLOTB = 8192;
constexpr int NSLOT = 6, PD = NSLOT - 1;
constexpr int LDS_K = 0, LDS_V = NSLOT * SLOTB, LDS_Q = 2 * NSLOT * SLOTB, LDS_OST = LDS_Q + 4 * 4096, LDS_BYTES = LDS_OST + 4 * 4096;
__device__ __forceinline__ int crow(int r, int hi) { return (r & 3) + 8 * (r >> 2) + 4 * hi; }
__device__ __forceinline__ void glds16(const void* gsrc, unsigned lds_dst) { unsigned keep;
    asm volatile("s_mov_b32 %0, m0\n\ts_mov_b32 m0, %2\n\ts_nop 0\n\tglobal_load_lds_dwordx4 %1, off\n\ts_mov_b32 m0, %0" : "=&s"(keep) : "v"(gsrc), "s"(lds_dst) : "memory"); }
typedef float f32x2_t __attribute__((ext_vector_type(2))); typedef __bf16 bf16x2_t __attribute__((ext_vector_type(2)));
__device__ __forceinline__ unsigned cvtpk(float lo, float hi) { f32x2_t v = {lo, hi}; bf16x2_t b = __builtin_convertvector(v, bf16x2_t); return __builtin_bit_cast(unsigned, b); }
__device__ __forceinline__ void qkt(f32x16& p0, f32x16& p1, lds_cptr Kslot, const bf16x8* qr, const f32x16& c0, int r32, int hi) {
    lds_cptr kb = Kslot + hi * 1024 + r32 * 16;
#pragma unroll
    for (int d0 = 0; d0 < 4; ++d0) {
        const bf16x8 b0 = *(const __attribute__((address_space(3))) bf16x8*)(kb + d0 * 2048);
        const bf16x8 b1 = *(const __attribute__((address_space(3))) bf16x8*)(kb + d0 * 2048 + 512);
        if (d0 == 0) { p0 = __builtin_amdgcn_mfma_f32_32x32x16_bf16(b0, qr[0], c0, 0, 0, 0); p1 = __builtin_amdgcn_mfma_f32_32x32x16_bf16(b1, qr[0], c0, 0, 0, 0); }
        else { p0 = __builtin_amdgcn_mfma_f32_32x32x16_bf16(b0, qr[d0], p0, 0, 0, 0); p1 = __builtin_amdgcn_mfma_f32_32x32x16_bf16(b1, qr[d0], p1, 0, 0, 0); } }
}
__device__ __forceinline__ void pv(f32x16* o, int vb, bf16x8 pa0, bf16x8 pa1, bf16x8 pa2, bf16x8 pa3) {
#pragma unroll
    for (int d0 = 0; d0 < 2; ++d0) { s16x4 lo[4], hi[4];
#pragma unroll
        for (int ks = 0; ks < 4; ++ks) {
            asm volatile("ds_read_b64_tr_b16 %0,%1 offset:%c2" : "=&v"(lo[ks]) : "v"(vb), "i"(d0 * 4096 + ks * 1024) : "memory");
            asm volatile("ds_read_b64_tr_b16 %0,%1 offset:%c2" : "=&v"(hi[ks]) : "v"(vb), "i"(d0 * 4096 + ks * 1024 + 512) : "memory"); }
        asm volatile("s_waitcnt lgkmcnt(0)" ::: "memory"); __builtin_amdgcn_sched_barrier(0);
#define SB_PK(k) (bf16x8){lo[k][0], lo[k][1], lo[k][2], lo[k][3], hi[k][0], hi[k][1], hi[k][2], hi[k][3]}
        o[d0] = __builtin_amdgcn_mfma_f32_32x32x16_bf16(pa0, SB_PK(0), o[d0], 0, 0, 0);
        o[d0] = __builtin_amdgcn_mfma_f32_32x32x16_bf16(pa1, SB_PK(1), o[d0], 0, 0, 0);
        o[d0] = __builtin_amdgcn_mfma_f32_32x32x16_bf16(pa2, SB_PK(2), o[d0], 0, 0, 0);
        o[d0] = __builtin_amdgcn_mfma_f32_32x32x16_bf16(pa3, SB_PK(3), o[d0], 0, 0, 0);
#undef SB_PK
    }
}
__device__ __forceinline__ f16x8 l8(const f32x16& l, int b) { return (f16x8){(_Float16)l[b], (_Float16)l[b + 1], (_Float16)l[b + 2], (_Float16)l[b + 3], (_Float16)l[b + 4], (_Float16)l[b + 5], (_Float16)l[b + 6], (_Float16)l[b + 7]}; }
__device__ __forceinline__ void grp_arrive_wait(__attribute__((address_space(3))) unsigned* cnt, unsigned& epoch, int lane) {
    epoch += 4u;
    if (lane == 0) (void)__hip_atomic_fetch_add(cnt, 1u, __ATOMIC_RELAXED, __HIP_MEMORY_SCOPE_WORKGROUP);
    unsigned spins = 0;
    while ((unsigned)__builtin_amdgcn_readfirstlane((int)__hip_atomic_load(cnt, __ATOMIC_RELAXED, __HIP_MEMORY_SCOPE_WORKGROUP)) < epoch) { __builtin_amdgcn_s_sleep(1); if (++spins > (1u << 22)) break; }
    asm volatile("" ::: "memory");
}
__device__ __forceinline__ void grp_bar(__attribute__((address_space(3))) unsigned* cnt, unsigned& epoch, int lane) {
    asm volatile("s_waitcnt vmcnt(0) lgkmcnt(0)" ::: "memory");
    grp_arrive_wait(cnt, epoch, lane);
}
__device__ __forceinline__ void grp_bar_counted(__attribute__((address_space(3))) unsigned* cnt, unsigned& epoch, int lane, int ntile) {
    if (ntile >= 4) asm volatile("s_waitcnt vmcnt(16) lgkmcnt(0)" ::: "memory");
    else if (ntile == 3) asm volatile("s_waitcnt vmcnt(12) lgkmcnt(0)" ::: "memory");
    else if (ntile == 2) asm volatile("s_waitcnt vmcnt(8) lgkmcnt(0)" ::: "memory");
    else if (ntile == 1) asm volatile("s_waitcnt vmcnt(4) lgkmcnt(0)" ::: "memory");
    else asm volatile("s_waitcnt vmcnt(0) lgkmcnt(0)" ::: "memory");
    grp_arrive_wait(cnt, epoch, lane);
}
__device__ __forceinline__ void attn_unit4(int b, int h, int qb16, int wid4, const unsigned short* Qb, const unsigned short* __restrict__ Kb, const unsigned short* __restrict__ Vb, unsigned short* AM, float bias2, char* shm,
                                           __attribute__((address_space(3))) unsigned* cnt, unsigned& epoch) {
    const int tid = tid_now(), lane = tid & 63, r32 = lane & 31, hi = lane >> 5;
    const unsigned short* Qw = Qb + (size_t)(b * TSEQ + qb16 * 128 + wid4 * 32) * DATT + h * HDIM;
    const unsigned short* Kh = Kb + (size_t)b * KPAD * DATT + h * HDIM; const unsigned short* Vh = Vb + (size_t)b * KPAD * DATT + h * HDIM;
    const unsigned lds0 = (unsigned)(uintptr_t)shm;
    const lds_cptr shm3 = (lds_cptr)shm;
    const unsigned short* ksrc0 = Kh + (size_t)lane * DATT + wid4 * 8; const unsigned short* ksrc1 = ksrc0 + 32;
    const unsigned short* vsrc0 = Vh + (size_t)(16 * wid4 + (lane >> 2)) * DATT + (lane & 3) * 8; const unsigned short* vsrc1 = vsrc0 + 32;
    const unsigned kdst = lds0 + LDS_K + wid4 * 1024, vdst = lds0 + LDS_V + wid4 * 1024;
#define SB_DMA(j, bo) do { const size_t to_ = (size_t)(j) * 64 * DATT; glds16(ksrc0 + to_, (unsigned)__builtin_amdgcn_readfirstlane(kdst + (bo))); glds16(ksrc1 + to_, (unsigned)__builtin_amdgcn_readfirstlane(kdst + (bo) + 4096)); \
        glds16(vsrc0 + to_, (unsigned)__builtin_amdgcn_readfirstlane(vdst + (bo))); glds16(vsrc1 + to_, (unsigned)__builtin_amdgcn_readfirstlane(vdst + (bo) + 4096)); } while (0)
    const int vb0 = (int)(lds0 + LDS_V) + ((lane >> 4) & 1) * 32 + (lane & 3) * 8 + (4 * hi + ((lane & 15) >> 2)) * 64;
    const lds_cptr kp0 = shm3 + LDS_K;
    const unsigned qdst = lds0 + LDS_Q + wid4 * 4096;
#pragma unroll
    for (int d0 = 0; d0 < 4; ++d0) glds16(Qw + (size_t)r32 * DATT + d0 * 16 + hi * 8, (unsigned)__builtin_amdgcn_readfirstlane(qdst + d0 * 1024));
    bf16x8 qr[4];
    f16x8 Ta, Tb, On;
#pragma unroll
    for (int jj = 0; jj < 8; ++jj) { const int key = (jj & 3) + 8 * (jj >> 2) + 4 * hi; Ta[jj] = key > r32 ? (_Float16)(-1.f) : (_Float16)0.f; Tb[jj] = (16 + key) > r32 ? (_Float16)(-1.f) : (_Float16)0.f; On[jj] = (_Float16)(-1.f); }
    f32x16 cb;
#pragma unroll
    for (int r = 0; r < 16; ++r) cb[r] = bias2;
    f32x16 o[2]; o[0] = f32x16{}; o[1] = f32x16{};
    float carry = 0.f;
    const int jmax = 2 * qb16 + 2, jd = 2 * qb16 + 1 + (wid4 >> 1);
    const int lim = 32 * (wid4 & 1) + r32;
    int slot = 0;
    { int sl = 0;
#pragma unroll 1
      for (int t = jmax; t > jmax - PD && t >= 0; --t) { SB_DMA(t, sl * SLOTB); ++sl; } }
    for (int j = jmax; j >= 0; --j) {
        grp_bar_counted(cnt, epoch, lane, j < PD - 1 ? j : PD - 1);
        if (j == jmax) {
#pragma unroll
            for (int d0 = 0; d0 < 4; ++d0) qr[d0] = *(const __attribute__((address_space(3))) bf16x8*)(shm3 + LDS_Q + wid4 * 4096 + d0 * 1024 + lane * 16);
        }
        if (j - PD >= 0) { const int ns = (slot == 0) ? NSLOT - 1 : slot - 1; SB_DMA(j - PD, ns * SLOTB); }
        const int buf = slot;
        if (j <= jd) {
            f32x16 p0, p1;
            qkt(p0, p1, kp0 + buf * SLOTB, qr, cb, r32, hi);
            if (j == jd) {
#pragma unroll
                for (int r = 0; r < 16; ++r) { const int kk = crow(r, hi); if (kk >= lim) p0[r] = -200.f; if (kk + 32 >= lim) p1[r] = -200.f; }
            }
            if (j == 0) {
#pragma unroll
                for (int r = 0; r < 16; ++r) { const int kk = crow(r, hi); p0[r] = -200.f; if (kk + 32 < 48) p1[r] = -200.f; }
            }
            f32x16 l0, l1;
#pragma unroll
            for (int r = 0; r < 16; ++r) { p0[r] = fminf(p0[r], 126.f); p1[r] = fminf(p1[r], 126.f);
                l0[r] = __builtin_amdgcn_logf(1.f + __builtin_amdgcn_exp2f(p0[r])); l1[r] = __builtin_amdgcn_logf(1.f + __builtin_amdgcn_exp2f(p1[r])); }
            const float z0 = p0[0];
            f32x16 s0, s1;
#pragma unroll
            for (int r = 0; r < 16; ++r) { s0[r] = (p0[r] - l0[r]) + carry; s1[r] = (p1[r] - l1[r]) + carry; }
            const f16x8 sl0 = l8(l0, 0), sl1 = l8(l0, 8), sl2 = l8(l1, 0), sl3 = l8(l1, 8);
            s0 = __builtin_amdgcn_mfma_f32_32x32x16_f16(Ta, sl0, s0, 0, 0, 0);
            s0 = __builtin_amdgcn_mfma_f32_32x32x16_f16(Tb, sl1, s0, 0, 0, 0);
            s0 = __builtin_amdgcn_mfma_f32_32x32x16_f16(On, sl2, s0, 0, 0, 0);
            s0 = __builtin_amdgcn_mfma_f32_32x32x16_f16(On, sl3, s0, 0, 0, 0);
            s1 = __builtin_amdgcn_mfma_f32_32x32x16_f16(Ta, sl2, s1, 0, 0, 0);
            s1 = __builtin_amdgcn_mfma_f32_32x32x16_f16(Tb, sl3, s1, 0, 0, 0);
            const float nc = s0[0] - z0;
            carry = __shfl(nc, r32);
#pragma unroll
            for (int r = 0; r < 16; ++r) { s0[r] = __builtin_amdgcn_exp2f(s0[r]); s1[r] = __builtin_amdgcn_exp2f(s1[r]); }
            u32x4 pw0 = (u32x4){cvtpk(s0[0], s0[1]), cvtpk(s0[2], s0[3]), cvtpk(s0[4], s0[5]), cvtpk(s0[6], s0[7])};
            u32x4 pw1 = (u32x4){cvtpk(s0[8], s0[9]), cvtpk(s0[10], s0[11]), cvtpk(s0[12], s0[13]), cvtpk(s0[14], s0[15])};
            u32x4 pw2 = (u32x4){cvtpk(s1[0], s1[1]), cvtpk(s1[2], s1[3]), cvtpk(s1[4], s1[5]), cvtpk(s1[6], s1[7])};
            u32x4 pw3 = (u32x4){cvtpk(s1[8], s1[9]), cvtpk(s1[10], s1[11]), cvtpk(s1[12], s1[13]), cvtpk(s1[14], s1[15])};
            pv(o, vb0 + buf * SLOTB, __builtin_bit_cast(bf16x8, pw0), __builtin_bit_cast(bf16x8, pw1), __builtin_bit_cast(bf16x8, pw2), __builtin_bit_cast(bf16x8, pw3));
        }
        slot = (slot == NSLOT - 1) ? 0 : slot + 1;
    }
#undef SB_DMA
    unsigned short* Ow = AM + (size_t)(b * TSEQ + qb16 * 128 + wid4 * 32) * D + h * HDIM;
    { __hip_bfloat16* stg = (__hip_bfloat16*)(shm + LDS_OST) + wid4 * 2048;
#pragma unroll
        for (int r = 0; r < 16; ++r) { const int orow = crow(r, hi);
#pragma unroll
            for (int d0 = 0; d0 < 2; ++d0) stg[orow * 64 + d0 * 32 + r32] = __float2bfloat16(o[d0][r]); }
        asm volatile("s_waitcnt lgkmcnt(0)" ::: "memory");
#pragma unroll
        for (int i = 0; i < 4; ++i) { const int row = i * 8 + (lane >> 3), ch = lane & 7; const u32x4 v = *(const u32x4*)(stg + row * 64 + ch * 8); *(u32x4*)(Ow + (size_t)row * D + ch * 8) = v; } }
    grp_bar(cnt, epoch, lane);
}
}

namespace sm {
typedef short bf16x8 __attribute__((ext_vector_type(8)));
typedef float f32x4 __attribute__((ext_vector_type(4)));
typedef unsigned u32x2 __attribute__((ext_vector_type(2)));
__device__ __forceinline__ u32x2 pack4(const f32x4 a) { u32x2 w; w.x = pg8::cvt_pk_bf16(a[0], a[1]); w.y = pg8::cvt_pk_bf16(a[2], a[3]); return w; }
__device__ __forceinline__ f32x4 unpack4(const u32x2 w) { return (f32x4){pg8::bf_lo(w.x), pg8::bf_hi(w.x), pg8::bf_lo(w.y), pg8::bf_hi(w.y)}; }
template <int NRT, bool MERGE, class EpiS>
__device__ __forceinline__ void small_job(__attribute__((address_space(3))) unsigned char* lds, const unsigned short* A, int K, const unsigned short* Bt, int colA0, int colB0, int row0, const EpiS& E) {
    const int tid = tid_now(), lane = tid & 63, fr = lane & 15, fq = lane >> 4, wid = __builtin_amdgcn_readfirstlane(tid >> 6);
    const int kw = K >> 3, kbase = wid * kw, steps = kw >> 5;
    f32x4 acc[NRT][2];
#pragma unroll
    for (int rt = 0; rt < NRT; ++rt) { acc[rt][0] = (f32x4){0.f, 0.f, 0.f, 0.f}; acc[rt][1] = (f32x4){0.f, 0.f, 0.f, 0.f}; }
    const unsigned short* ap = A + (size_t)fr * K + kbase + 8 * fq;
    const unsigned short* bpA = Bt + (size_t)(colA0 + fr) * K + kbase + 8 * fq;
    const unsigned short* bpB = Bt + (size_t)(colB0 + fr) * K + kbase + 8 * fq;
#pragma unroll 4
    for (int s = 0; s < steps; ++s) {
        const bf16x8 b0 = *(const bf16x8*)(bpA + s * 32), b1 = *(const bf16x8*)(bpB + s * 32);
        bf16x8 a[NRT];
#pragma unroll
        for (int rt = 0; rt < NRT; ++rt) a[rt] = *(const bf16x8*)(ap + (size_t)rt * 16 * K + s * 32);
#pragma unroll
        for (int rt = 0; rt < NRT; ++rt) { acc[rt][0] = __builtin_amdgcn_mfma_f32_16x16x32_bf16(b0, a[rt], acc[rt][0], 0, 0, 0); acc[rt][1] = __builtin_amdgcn_mfma_f32_16x16x32_bf16(b1, a[rt], acc[rt][1], 0, 0, 0); }
    }
    __attribute__((address_space(3))) f32x4* part = (__attribute__((address_space(3))) f32x4*)lds;
#pragma unroll
    for (int rt = 0; rt < NRT; ++rt) { part[((wid * NRT + rt) * 2 + 0) * 64 + lane] = acc[rt][0]; part[((wid * NRT + rt) * 2 + 1) * 64 + lane] = acc[rt][1]; }
    asm volatile("s_waitcnt lgkmcnt(0)" ::: "memory"); __syncthreads();
    if (tid < NRT * 64) {
        const int rt = tid >> 6;
        f32x4 va = (f32x4){0.f, 0.f, 0.f, 0.f}, vb = va, va2 = va, vb2 = va;
#pragma unroll
        for (int w = 0; w < 8; ++w) { const f32x4 pa = part[((w * NRT + rt) * 2 + 0) * 64 + lane], pb = part[((w * NRT + rt) * 2 + 1) * 64 + lane];
            if (MERGE && w >= 4) { va2 += pa; vb2 += pb; } else { va += pa; vb += pb; } }
        E(row0 + rt * 16 + fr, colA0 + 4 * fq, va, colB0 + 4 * fq, vb, va2, vb2);
    }
    __syncthreads();
}
__device__ __forceinline__ void job_cols(int j, bool paired, int& cA, int& cB) { if (paired) { cA = (j >> 3) * 256 + (j & 7) * 16; cB = cA + 128; } else { cA = j * 32; cB = cA + 16; } }

struct EpiS1 {
    unsigned short *Qb, *Kb, *Vb, *BG, *U, *G; float* out;
    __device__ __forceinline__ void kv(int row, int c, const f32x4 v) const {
        const bool isv = c >= 1024; unsigned short* KV = isv ? Vb : Kb; float* outp = out + (isv ? OFF_VP : OFF_KP); float* outs = out + (isv ? OFF_VS : OFF_KS); const int col = c - (isv ? 1024 : 512);
        if (row < ROW_SAMP) { const int i = row - ROW_META; const u32x2 w = pack4(v);
            for (int b = 0; b < NBATCH; ++b) { *(u32x2*)(KV + (size_t)(b * KPAD + 48 + i) * DATT + col) = w; *(f32x4*)(outp + (size_t)(b * LSEQ + i) * DATT + col) = v; } }
        else *(f32x4*)(outs + (size_t)(row - ROW_SAMP) * DATT + col) = v;
    }
    __device__ __forceinline__ void operator()(int row, int cA, const f32x4 va, int cB, const f32x4 vb, const f32x4, const f32x4) const {
        const int pn = cA >> 8;
        if (pn < 2) { *(u32x2*)(Qb + (size_t)row * DATT + cA) = pack4(va * C2); *(u32x2*)(Qb + (size_t)row * DATT + cB) = pack4(vb * C2); }
        else if (pn < 6) { kv(row, cA, va); kv(row, cB, vb); }
        else if (pn < 8) { *(u32x2*)(BG + (size_t)row * DCONV + (cA - 1536)) = pack4(va); *(u32x2*)(BG + (size_t)row * DCONV + (cB - 1536)) = pack4(vb); }
        else if (pn < 12) { const int ch = (pn - 8) * 128 + (cA & 127); const f32x4 u = va * vb; *(u32x2*)(U + (size_t)row * DCONV + ch) = pack4(u);
            if (row >= ROW_SAMP) *(f32x4*)(out + OFF_CS + (size_t)((row - ROW_SAMP) * 2 + 1) * DCONV + ch) = u; }
        else { const int ch = (pn - 12) * 128 + (cA & 127); f32x4 r, s;
#pragma unroll
            for (int e = 0; e < 4; ++e) { const float ga = fminf(fmaxf(va[e], -30.f), 30.f), gb = fminf(fmaxf(vb[e], -30.f), 30.f);
                const float ea = __builtin_amdgcn_exp2f(-ga * LOG2E), eb = __builtin_amdgcn_exp2f(-gb * LOG2E); r[e] = (1.f + eb) * __builtin_amdgcn_rcpf(1.f + ea); s[e] = __builtin_amdgcn_rcpf(1.f + eb); }
            *(u32x2*)(G + (size_t)row * 2048 + ch) = pack4(r); *(u32x2*)(G + (size_t)row * 2048 + 1024 + ch) = pack4(s); }
    }
};
struct EpiS3 {
    const unsigned short* G; unsigned short* Mb;
    __device__ __forceinline__ void one(int row, int c, const f32x4 ya, const f32x4 yb) const {
        const f32x4 r = unpack4(*(const u32x2*)(G + (size_t)row * 2048 + c)), s = unpack4(*(const u32x2*)(G + (size_t)row * 2048 + 1024 + c));
        *(u32x2*)(Mb + (size_t)row * D + c) = pack4((ya * r + yb) * s); }
    __device__ __forceinline__ void operator()(int row, int cA, const f32x4 va, int cB, const f32x4 vb, const f32x4 va2, const f32x4 vb2) const { one(row, cA, va, va2); one(row, cB, vb, vb2); }
};
struct EpiS4 {
    pg8::RowMap R; unsigned short* X1b; float* rowsum;
    __device__ __forceinline__ void operator()(int row, int cA, const f32x4 va, int cB, const f32x4 vb, const f32x4, const f32x4) const {
        const float* xi = R.xin(row); float* xo = R.x1(row);
        const f32x4 a = *(const f32x4*)(xi + cA) + va, b = *(const f32x4*)(xi + cB) + vb;
        *(f32x4*)(xo + cA) = a; *(f32x4*)(xo + cB) = b; *(u32x2*)(X1b + (size_t)row * D + cA) = pack4(a); *(u32x2*)(X1b + (size_t)row * D + cB) = pack4(b);
        unsafeAtomicAdd(rowsum + row, (a[0] * a[0] + a[1] * a[1]) + (a[2] * a[2] + a[3] * a[3]) + (b[0] * b[0] + b[1] * b[1]) + (b[2] * b[2] + b[3] * b[3]));
    }
};
struct EpiS5 {
    const float* rowsum; unsigned short* ACT;
    __device__ __forceinline__ void operator()(int row, int cA, const f32x4 va, int cB, const f32x4 vb, const f32x4, const f32x4) const {
        const float rstd = __builtin_amdgcn_rsqf(rowsum[row] * (1.0f / D) + EPS); f32x4 o;
#pragma unroll
        for (int e = 0; e < 4; ++e) { const float g = va[e] * rstd, up = vb[e] * rstd; o[e] = g * __builtin_amdgcn_rcpf(1.f + __builtin_amdgcn_exp2f(-g * LOG2E)) * up; }
        *(u32x2*)(ACT + (size_t)row * FF + (cA >> 8) * 128 + (cA & 127)) = pack4(o);
    }
};
struct EpiS6 {
    pg8::RowMap R; float* rowsum;
    __device__ __forceinline__ void operator()(int row, int cA, const f32x4 va, int cB, const f32x4 vb, const f32x4, const f32x4) const {
        float* xo = R.x1(row);
        const f32x4 a = *(const f32x4*)(xo + cA) + va, b = *(const f32x4*)(xo + cB) + vb;
        *(f32x4*)(xo + cA) = a; *(f32x4*)(xo + cB) = b;
        unsafeAtomicAdd(rowsum + row, (a[0] * a[0] + a[1] * a[1]) + (a[2] * a[2] + a[3] * a[3]) + (b[0] * b[0] + b[1] * b[1]) + (b[2] * b[2] + b[3] * b[3]));
    }
};
}

constexpr int NWAVES = 8;
constexpr int N_PHASES = 8;
#ifndef PROBE_DUP
#define PROBE_DUP -1
#endif
#ifndef MK_ONE_LAUNCH
#define MK_ONE_LAUNCH 1
#endif
constexpr size_t MiB = 1u << 20;
constexpr size_t WS_CTL = 0, CTL_ZERO_BYTES = 1 * MiB;
constexpr size_t WS_W1 = 2 * MiB, WS_WM = 12 * MiB, WS_WO = 14 * MiB, WS_WGU = 16 * MiB, WS_WD = 27 * MiB;
constexpr size_t WS_H = 33 * MiB, WS_Q = 66 * MiB, WS_K = 83 * MiB, WS_V = 100 * MiB, WS_BG = 117 * MiB, WS_U = 134 * MiB, WS_G = 151 * MiB;
constexpr size_t WS_AM = 216 * MiB, WS_MB = 249 * MiB, WS_X1B = 282 * MiB, WS_ACT = 315 * MiB, WS_X1S = 405 * MiB, WS_END = 406 * MiB;
static_assert(WS_W1 + (size_t)NIN * D * 2 <= WS_WM && WS_WGU + (size_t)NGU * D * 2 <= WS_WD && WS_WD + (size_t)D * FF * 2 <= WS_H && WS_H + (size_t)M_TOT * D * 2 <= WS_Q && WS_Q + (size_t)M_TOT * DATT * 2 <= WS_K
              && WS_K + (size_t)NBATCH * KPAD * DATT * 2 <= WS_V && WS_V + (size_t)NBATCH * KPAD * DATT * 2 <= WS_BG && WS_BG + (size_t)M_TOT * DCONV * 2 <= WS_U && WS_U + (size_t)M_TOT * DCONV * 2 <= WS_G
              && WS_G + (size_t)M_TOT * 2048 * 2 <= WS_AM && WS_AM + (size_t)M_TOT * D * 2 <= WS_MB && WS_MB + (size_t)M_TOT * D * 2 <= WS_X1B && WS_X1B + (size_t)M_TOT * D * 2 <= WS_ACT
              && WS_ACT + (size_t)M_TOT * FF * 2 <= WS_X1S && WS_X1S + (size_t)256 * D * 4 <= WS_END, "d_ws map");
constexpr int CW_BAR = 4096;
constexpr int CW_RS1 = 16384, CW_RS2 = 40960;
static_assert((CW_RS2 + M_TOT) * 4 <= (int)CTL_ZERO_BYTES, "CTL words inside the memset region");
constexpr int RING_OFF = 0, RING_BYTES = 131072;
constexpr int LDSCTL_OFF = RING_BYTES, MISC_OFF = LDSCTL_OFF + 320;
constexpr int LDS_BYTES = 147456;
static_assert(MISC_OFF + 128 <= LDS_BYTES, "LDS map");

#define GAS __attribute__((address_space(1)))
#define LAS __attribute__((address_space(3)))
typedef unsigned short bf16;
typedef unsigned v4u __attribute__((ext_vector_type(4)));
typedef float f32x4 __attribute__((ext_vector_type(4)));
typedef GAS unsigned gu32;
#define RLX_AGENT __ATOMIC_RELAXED, __HIP_MEMORY_SCOPE_AGENT
#define LDS_WAIT() asm volatile("s_waitcnt lgkmcnt(0)" ::: "memory")
#define VM_WAIT() asm volatile("s_waitcnt vmcnt(0)" ::: "memory")
__device__ __forceinline__ unsigned f2bf(float f) { unsigned u = __builtin_bit_cast(unsigned, f); return (u + 0x7fffu + ((u >> 16) & 1u)) >> 16; }
__device__ __forceinline__ unsigned pk2(float lo, float hi) { return f2bf(lo) | (f2bf(hi) << 16); }
__device__ __forceinline__ float bfl(unsigned w) { return __builtin_bit_cast(float, w << 16); }
__device__ __forceinline__ float bfh(unsigned w) { return __builtin_bit_cast(float, w & 0xffff0000u); }

#define XB_TMO      128
#define XB_XCNT(j)  (256  + 64 * (j))
#define XB_XSUB(j)  (1280 + 64 * (j))
#define XB_XGEN(j)  (2304 + 64 * (j))
#define XB_TOP      3328
#define XB_TOPGEN   3392
#define XCD_BAR_WORDS 3456
#define XB_SPIN_CAP (1u << 18)

__device__ __forceinline__ unsigned xb_ld(unsigned* p)              { return __hip_atomic_load(p, __ATOMIC_RELAXED, __HIP_MEMORY_SCOPE_AGENT); }
__device__ __forceinline__ unsigned xb_add(unsigned* p, unsigned v) { return __hip_atomic_fetch_add(p, v, __ATOMIC_RELAXED, __HIP_MEMORY_SCOPE_AGENT); }
__device__ __forceinline__ unsigned xb_xcc_id() { return (unsigned)__builtin_amdgcn_s_getreg((3 << 11) | 20) & 0xFu; }
#define XB_SPIN(cond, bar) do { unsigned _sp = 0; while (cond) { __builtin_amdgcn_s_sleep(1); \
    if ((++_sp & 255u) == 0u) { if (xb_ld(&(bar)[XB_TMO])) break; if (_sp > XB_SPIN_CAP) { atomicAdd(&(bar)[XB_TMO], 1u); break; } } } } while (0)

struct XcdBarrier {
    unsigned* bar; unsigned x;
    volatile LAS unsigned* st;
};

__device__ __forceinline__ XcdBarrier xcd_barrier_post(unsigned* bar, volatile LAS unsigned* st) {
    XcdBarrier b; b.bar = bar; b.x = xb_xcc_id(); b.st = st;
    if (threadIdx.x == 0) (void)xb_add(&bar[XB_XCNT(b.x)], 1u);
    return b;
}
__device__ __forceinline__ void xcd_barrier_complete(unsigned* bar, unsigned x, unsigned& nloc, unsigned& nx) {
    const unsigned G = gridDim.x * gridDim.y * gridDim.z;
    unsigned sum, cnt, mine, sp = 0u;
    for (;;) {
        sum = 0u; cnt = 0u; mine = 0u;
#pragma unroll
        for (unsigned j = 0; j < 16; ++j) { const unsigned c = xb_ld(&bar[XB_XCNT(j)]); sum += c; cnt += (c > 0u) ? 1u : 0u; mine = (j == x) ? c : mine; }
        if (sum == G) break;
        __builtin_amdgcn_s_sleep(1);
        if ((++sp & 255u) == 0u) { if (xb_ld(&bar[XB_TMO])) break; if (sp > XB_SPIN_CAP) { atomicAdd(&bar[XB_TMO], 1u); break; } }
    }
    nloc = mine > 0u ? mine : 1u; nx = cnt > 0u ? cnt : 1u;
}

__device__ __forceinline__ void xcd_barrier(const XcdBarrier& b) {
    asm volatile("s_waitcnt vmcnt(0)" ::: "memory");
    __syncthreads();
    if (threadIdx.x == 0) {
        unsigned* bar = b.bar;
        __builtin_amdgcn_s_waitcnt(0);
        unsigned nloc = b.st[0], nx = b.st[1];
        if (nloc == 0u) { xcd_barrier_complete(bar, b.x, nloc, nx); b.st[0] = nloc; b.st[1] = nx; }
        const unsigned old = xb_add(&bar[XB_XSUB(b.x)], 1u);
        const unsigned gen = old / nloc;
        if (old + 1u == (gen + 1u) * nloc) {
            __builtin_amdgcn_fence(__ATOMIC_RELEASE, "agent");
            asm volatile("s_waitcnt vmcnt(0)" ::: "memory");
            const unsigned og = xb_add(&bar[XB_TOP], 1u);
            const unsigned tg = og / nx;
            if (og + 1u == (tg + 1u) * nx) xb_add(&bar[XB_TOPGEN], 1u);
            else XB_SPIN(xb_ld(&bar[XB_TOPGEN]) == tg, bar);
            __builtin_amdgcn_fence(__ATOMIC_ACQUIRE, "agent");
            xb_add(&bar[XB_XGEN(b.x)], 1u);
            asm volatile("s_waitcnt vmcnt(0)" ::: "memory");
        } else {
            XB_SPIN(xb_ld(&bar[XB_XGEN(b.x)]) == gen, bar);
            __builtin_amdgcn_fence(__ATOMIC_ACQUIRE, "agent");
            asm volatile("s_waitcnt vmcnt(0)" ::: "memory");
        }
    }
    __syncthreads();
}

struct Frame {
    LAS unsigned char* lds;
    volatile LAS unsigned* MISC;
    gu32* ctl;
    int wave;
    int vcu, G;
};
__device__ __forceinline__ float wave_sum(float v) {
#pragma unroll
    for (int o = 1; o < 64; o <<= 1) v += __shfl_xor(v, o);
    return v;
}
__device__ __forceinline__ void tr_item(const float* W, int ldw, int scol0, int k0, bf16* WT, int drow0, int dpitch, int dk0, const float* kscale, LAS float* scr, int lane) {
#pragma unroll 8
    for (int i = 0; i < 32; ++i) { const int kk = 2 * i + (lane >> 5); float v = __builtin_nontemporal_load(W + (size_t)(k0 + kk) * ldw + scol0 + (lane & 31));     if (kscale) v *= kscale[k0 + kk]; scr[kk * 33 + (lane & 31)] = v; }
    LDS_WAIT(); asm volatile("" ::: "memory");
    const int c = lane & 7;
#pragma unroll
    for (int j = 0; j < 4; ++j) { const int n = (lane >> 3) + 8 * j; const LAS float* s = scr + (8 * c) * 33 + n;
        v4u o; o.x = pk2(s[0 * 33], s[1 * 33]); o.y = pk2(s[2 * 33], s[3 * 33]); o.z = pk2(s[4 * 33], s[5 * 33]); o.w = pk2(s[6 * 33], s[7 * 33]);
        *(GAS v4u*)(WT + (size_t)(drow0 + n) * dpitch + dk0 + k0 + 8 * c) = o; }
    LDS_WAIT(); asm volatile("" ::: "memory");
}
struct Args { const float* in[19]; float* out; unsigned char* ws; int ph_lo, ph_hi; };
static_assert(sizeof(Args) == 19 * 8 + 8 + 8 + 8, "Args has no padding");

__device__ __forceinline__ void p0_prologue(Frame& F, const Args& A, unsigned char* ws) {
    LAS float* scr = (LAS float*)(F.lds + RING_OFF + F.wave * 16384); const int lane = tid_now() & 63;
    const int gw = F.vcu * NWAVES + F.wave, NGW = F.G * NWAVES;
    const float* w_in = A.in[8]; const float* w_att_out = A.in[11]; const float* w_conv_out = A.in[12]; const float* w_o = A.in[13]; const float* norm_ffn = A.in[14];
    const float* w_gate = A.in[15]; const float* w_up = A.in[16]; const float* w_down = A.in[17];
    bf16* W1t = (bf16*)(ws + WS_W1); bf16* Wmt = (bf16*)(ws + WS_WM); bf16* Wot = (bf16*)(ws + WS_WO); bf16* Wgut = (bf16*)(ws + WS_WGU); bf16* Wdt = (bf16*)(ws + WS_WD);
    constexpr int I_1 = 16 * 160, I_MA = 8 * 32, I_MB = 8 * 32, I_O = 16 * 32, I_GU = 16 * 176, I_D = 44 * 32;
    constexpr int NITEMS = I_1 + I_MA + I_MB + I_O + I_GU + I_D;
    for (int it = gw; it < NITEMS; it += NGW) {
        int r = it;
        if (r < I_1) { const int kb = r / 160, nb = r % 160, n0 = nb * 32; int sc;
            if (n0 < 2048) sc = n0;
            else if (n0 < 3072) { const int i = (n0 - 2048) >> 8, w = (n0 - 2048) & 255; sc = w < 128 ? 2048 + 128 * i + w : 2560 + 128 * i + (w - 128); }
            else { const int i = (n0 - 3072) >> 8, w = (n0 - 3072) & 255; sc = w < 128 ? 3072 + 128 * i + w : 4096 + 128 * i + (w - 128); }
            tr_item(w_in, NIN, sc, kb * 64, W1t, n0, D, 0, nullptr, scr, lane); continue; } r -= I_1;
        if (r < I_MA) { const int kb = r / 32, nb = r % 32; tr_item(w_att_out, D, nb * 32, kb * 64, Wmt, nb * 32, D, 0, nullptr, scr, lane); continue; } r -= I_MA;
        if (r < I_MB) { const int kb = r / 32, nb = r % 32; tr_item(w_conv_out, D, nb * 32, kb * 64, Wmt, nb * 32, D, 512, nullptr, scr, lane); continue; } r -= I_MB;
        if (r < I_O) { const int kb = r / 32, nb = r % 32; tr_item(w_o, D, nb * 32, kb * 64, Wot, nb * 32, D, 0, nullptr, scr, lane); continue; } r -= I_O;
        if (r < I_GU) { const int kb = r / 176, nb = r % 176, n0 = nb * 32, i = n0 >> 8, w = n0 & 255;
            if (w < 128) tr_item(w_gate, FF, 128 * i + w, kb * 64, Wgut, n0, D, 0, norm_ffn, scr, lane);
            else tr_item(w_up, FF, 128 * i + (w - 128), kb * 64, Wgut, n0, D, 0, norm_ffn, scr, lane);
            continue; } r -= I_GU;
        { const int kb = r / 32, nb = r % 32; tr_item(w_down, D, nb * 32, kb * 64, Wdt, nb * 32, FF, 0, nullptr, scr, lane); }
    }
    const float* xp = A.in[0]; const float* xs = A.in[1]; const float* meta = A.in[6]; const float* gmix = A.in[7]; bf16* Hb = (bf16*)(ws + WS_H);
    f32x4 gv[4];
#pragma unroll
    for (int j = 0; j < 4; ++j) gv[j] = ((const GAS f32x4*)gmix)[lane + 64 * j];
    for (int m = gw; m < M_TOT; m += NGW) {
        GAS unsigned long long* o8 = (GAS unsigned long long*)(Hb + (size_t)m * D) + lane;
        if (m >= ROW_END) {
#pragma unroll
            for (int j = 0; j < 4; ++j) o8[64 * j] = 0ull;
            continue; }
        const float* xrow = m < MMAIN ? xp + (size_t)m * D : m < ROW_SAMP ? meta + (size_t)(m - ROW_META) * D : xs + (size_t)(m - ROW_SAMP) * D;
        const GAS f32x4* xr = (const GAS f32x4*)xrow + lane;
        f32x4 v[4]; float s2 = 0.f;
#pragma unroll
        for (int j = 0; j < 4; ++j) { v[j] = __builtin_nontemporal_load(xr + 64 * j); s2 += (v[j].x * v[j].x + v[j].y * v[j].y) + (v[j].z * v[j].z + v[j].w * v[j].w); }
        const float rstd = 1.f / sqrtf(wave_sum(s2) * (1.f / D) + EPS);
#pragma unroll
        for (int j = 0; j < 4; ++j) { const f32x4 y = v[j] * rstd * gv[j]; o8[64 * j] = (unsigned long long)pk2(y.x, y.y) | ((unsigned long long)pk2(y.z, y.w) << 32); }
    }
}

__device__ __forceinline__ void p2_conv(Frame& F, const Args& A, unsigned char* ws, int gw, int NGW) {
    const bf16* U = (const bf16*)(ws + WS_U); const bf16* BG = (const bf16*)(ws + WS_BG); bf16* AM = (bf16*)(ws + WS_AM);
    const float* convw = A.in[10]; const float* state = A.in[4];
    const int c8 = (tid_now() & 63) * 8;
    f32x4 w0a = *(const f32x4*)(convw + c8), w0b = *(const f32x4*)(convw + c8 + 4), w1a = *(const f32x4*)(convw + DCONV + c8), w1b = *(const f32x4*)(convw + DCONV + c8 + 4), w2a = *(const f32x4*)(convw + 2 * DCONV + c8), w2b = *(const f32x4*)(convw + 2 * DCONV + c8 + 4);
    for (int rr = gw; rr < MMAIN + NSAMP; rr += NGW) {
        f32x4 ua, ub, pa, pb, qa, qb; int row;
        if (rr < MMAIN) { row = rr; const int t = row & 2047;
            const int r1 = t >= 1 ? row - 1 : ROW_META + 15, r2 = t >= 2 ? row - 2 : ROW_META + 14 + t;
            pg8::unpack8(*(const v4u*)(U + (size_t)row * DCONV + c8), ua, ub); pg8::unpack8(*(const v4u*)(U + (size_t)r1 * DCONV + c8), pa, pb); pg8::unpack8(*(const v4u*)(U + (size_t)r2 * DCONV + c8), qa, qb);
        } else { const int s = rr - MMAIN; row = ROW_SAMP + s;
            pg8::unpack8(*(const v4u*)(U + (size_t)row * DCONV + c8), ua, ub);
            const float* s0 = state + (size_t)(s * 2 + 0) * DCONV + c8; const float* s1 = state + (size_t)(s * 2 + 1) * DCONV + c8;
            qa = *(const f32x4*)s0; qb = *(const f32x4*)(s0 + 4); pa = *(const f32x4*)s1; pb = *(const f32x4*)(s1 + 4);
            float* o = A.out + OFF_CS + (size_t)(s * 2 + 0) * DCONV + c8; *(f32x4*)o = pa; *(f32x4*)(o + 4) = pb; }
        f32x4 ga, gb; pg8::unpack8(*(const v4u*)(BG + (size_t)row * DCONV + c8), ga, gb);
        const f32x4 ya = ga * (w0a * qa + w1a * pa + w2a * ua), yb = gb * (w0b * qb + w1b * pb + w2b * ub);
        *(v4u*)(AM + (size_t)row * D + DATT + c8) = pg8::pack8(ya, yb);
    }
}

template <int CTRL, bool BC> __device__ __forceinline__ float dppf(float x) { return __builtin_bit_cast(float, __builtin_amdgcn_update_dpp(0, __builtin_bit_cast(int, x), CTRL, 0xF, 0xF, BC)); }
__device__ __forceinline__ float rdlane(float x, int l) { return __builtin_bit_cast(float, __builtin_amdgcn_readlane(__builtin_bit_cast(int, x), l)); }
__device__ __forceinline__ f32x4 ldnt(const float* p) { return __builtin_nontemporal_load((const f32x4*)p); }
__device__ __forceinline__ void p2_decode_unit4(const Args& A, unsigned char* ws, int s, int h, int dw, LAS float* part, LAS unsigned* cnt, unsigned& epoch) {
    const float* ck = A.in[2]; const float* cv = A.in[3]; const int* ptab = (const int*)A.in[5]; const float* sbb = A.in[9];
    const bf16* Qb = (const bf16*)(ws + WS_Q); bf16* AM = (bf16*)(ws + WS_AM);
    const int tid = tid_now(), lane = tid & 63, g = lane >> 4, j = lane & 15;
    const float bias2 = sbb[h] * LOG2E;
    f32x4 q4; { const unsigned long long qq = *(const unsigned long long*)(Qb + (size_t)(ROW_SAMP + s) * DATT + h * HDIM + 4 * j); q4 = (f32x4){bfl((unsigned)qq), bfh((unsigned)qq), bfl((unsigned)(qq >> 32)), bfh((unsigned)(qq >> 32))}; }
    f32x4 o4 = (f32x4){0.f, 0.f, 0.f, 0.f}; float carry = 0.f;
    const size_t loff = (size_t)(16 * g) * (NHEAD * HDIM) + h * HDIM + 4 * j;
    const int pvec = ptab[s * NPAGES + dw * 16 + (lane & 15)];
#define DEC_PAGE(k) ((size_t)__builtin_amdgcn_readlane(pvec, (k)))
    f32x4 kv[16], vv[16];
    { const size_t base = (DEC_PAGE(15) * PAGE + 64) * (NHEAD * HDIM) + loff;
#pragma unroll
      for (int i = 0; i < 16; ++i) kv[i] = ldnt(ck + base + (size_t)i * (NHEAD * HDIM)); }
    auto group = [&](const int gi, auto lastc) __attribute__((always_inline)) {
        const size_t base = (DEC_PAGE(15 - (gi >> 1)) * PAGE + (1 - (gi & 1)) * 64) * (NHEAD * HDIM) + loff;
#pragma unroll
        for (int i = 0; i < 16; ++i) vv[i] = ldnt(cv + base + (size_t)i * (NHEAD * HDIM));
        float zsel = 0.f;
#pragma unroll
        for (int i = 0; i < 16; ++i) { float p = (kv[i].x * q4.x + kv[i].y * q4.y) + (kv[i].z * q4.z + kv[i].w * q4.w);
            p += dppf<0x128, false>(p); p += dppf<0x124, false>(p); p += dppf<0x122, false>(p); p += dppf<0x121, false>(p);
            zsel = (j == i) ? p : zsel; }
        if constexpr (!decltype(lastc)::value) { const size_t nb = (DEC_PAGE(15 - ((gi + 1) >> 1)) * PAGE + (1 - ((gi + 1) & 1)) * 64) * (NHEAD * HDIM) + loff;
#pragma unroll
            for (int i = 0; i < 16; ++i) kv[i] = ldnt(ck + nb + (size_t)i * (NHEAD * HDIM)); }
        const float z2 = fminf(zsel + bias2, 126.f);
        const float lg = __builtin_amdgcn_logf(1.f + __builtin_amdgcn_exp2f(z2));
        float x = lg;
        x += dppf<0x101, true>(x); x += dppf<0x102, true>(x); x += dppf<0x104, true>(x); x += dppf<0x108, true>(x);
        const float t0 = rdlane(x, 0), t1 = rdlane(x, 16), t2 = rdlane(x, 32), t3 = rdlane(x, 48);
        x += (g == 0) ? (t1 + t2 + t3) : (g == 1) ? (t2 + t3) : (g == 2) ? t3 : 0.f;
        const float w = __builtin_amdgcn_exp2f((z2 - lg) - (x - lg) + carry);
        carry -= (t0 + t1) + (t2 + t3);
#define DEC_PV(i) { const float wb = dppf<0x150 + (i), false>(w); o4 += vv[i] * wb; }
        DEC_PV(0) DEC_PV(1) DEC_PV(2) DEC_PV(3) DEC_PV(4) DEC_PV(5) DEC_PV(6) DEC_PV(7) DEC_PV(8) DEC_PV(9) DEC_PV(10) DEC_PV(11) DEC_PV(12) DEC_PV(13) DEC_PV(14) DEC_PV(15)
#undef DEC_PV
    };
#pragma unroll 1
    for (int gi = 0; gi < 31; ++gi) group(gi, std::false_type{});
    group(31, std::true_type{});
#undef DEC_PAGE
#pragma unroll
    for (int e = 0; e < 4; ++e) { float t = o4[e]; t += __shfl_xor(t, 16); t += __shfl_xor(t, 32); o4[e] = t; }
    if (lane < 16) { *(LAS f32x4*)(part + dw * 68 + 4 * j) = o4; if (lane == 0) part[dw * 68 + 64] = carry; }
    sbattn::grp_bar(cnt, epoch, lane);
    if (dw == 0) { float acc = 0.f, cs = 0.f;
        for (int w = 3; w >= 0; --w) { acc += __builtin_amdgcn_exp2f(cs) * part[w * 68 + lane]; cs += part[w * 68 + 64]; }
        AM[(size_t)(ROW_SAMP + s) * D + h * HDIM + lane] = (bf16)f2bf(acc); }
    sbattn::grp_bar(cnt, epoch, lane);
}

__device__ __forceinline__ void p7_final(Frame& F, const Args& A, unsigned char* ws) {
    const float* gfin = A.in[18]; const float* rs2 = (const float*)(F.ctl + CW_RS2); const float* x1s = (const float*)(ws + WS_X1S); const bf16* X2b = (const bf16*)(ws + WS_MB);
    const int gw = F.vcu * NWAVES + F.wave, NGW = F.G * NWAVES, lane = tid_now() & 63;
    f32x4 gv[4];
#pragma unroll
    for (int j = 0; j < 4; ++j) gv[j] = ((const GAS f32x4*)gfin)[lane + 64 * j];
    f32x4 ga[2], gb[2];
#pragma unroll
    for (int j = 0; j < 2; ++j) { ga[j] = *(const f32x4*)(gfin + j * 512 + lane * 8); gb[j] = *(const f32x4*)(gfin + j * 512 + lane * 8 + 4); }
    for (int row = gw; row < MMAIN; row += NGW) {
        const float rstd = 1.f / sqrtf(rs2[row] * (1.f / D) + EPS);
#pragma unroll
        for (int j = 0; j < 2; ++j) { f32x4 a, b; pg8::unpack8(*(const v4u*)(X2b + (size_t)row * D + j * 512 + lane * 8), a, b);
            float* o = A.out + OFF_Y + (size_t)row * D + j * 512 + lane * 8; *(f32x4*)o = a * rstd * ga[j]; *(f32x4*)(o + 4) = b * rstd * gb[j]; }
    }
    for (int sidx = gw; sidx < NSAMP; sidx += NGW) {
        const int row = ROW_SAMP + sidx; const float* src = x1s + (size_t)(row - MMAIN) * D; float* dst = A.out + OFF_YS + (size_t)sidx * D;
        const float rstd = 1.f / sqrtf(rs2[row] * (1.f / D) + EPS);
#pragma unroll
        for (int j = 0; j < 4; ++j) { const f32x4 v = ((const GAS f32x4*)src)[lane + 64 * j]; ((GAS f32x4*)dst)[lane + 64 * j] = v * rstd * gv[j]; }
    }
}

__device__ __forceinline__ void p2_all(Frame& F, const Args& args, unsigned char* ws, unsigned char* lds, unsigned& epoch) {
    bf16* Qb = (bf16*)(ws + WS_Q); bf16* Kb = (bf16*)(ws + WS_K); bf16* Vb = (bf16*)(ws + WS_V); bf16* AM = (bf16*)(ws + WS_AM);
    const float* sbb = args.in[9];
    const int wid = F.wave;
    LAS unsigned* cntA = (LAS unsigned*)(F.lds + LDSCTL_OFF); LAS unsigned* cntD = cntA + 16;
    if (wid < 4) {
        for (int u = F.vcu; u < 256; u += F.G) {
            const int bh = u >> 2, qd = u & 3, b = bh >> 3, h = bh & 7; const float bias2 = sbb[h] * LOG2E;
#pragma unroll 1
            for (int kk = 0; kk < (PROBE_DUP == 2 ? 8 : 4); ++kk) { const int k = kk & 3; const int qb16 = (k == 0) ? 15 - qd : (k == 1) ? 11 - qd : (k == 2) ? 4 + qd : qd;
                sbattn::attn_unit4(b, h, qb16, wid, Qb, Kb, Vb, AM, bias2, (char*)lds + RING_OFF, cntA, epoch); }
        }
        p2_conv(F, args, ws, F.vcu * 4 + wid, F.G * 4);
    } else {
        for (int rep = 0; rep < (PROBE_DUP == 22 ? 2 : 1); ++rep) for (int u = (int)blockIdx.x; u < NSAMP * NHEAD; u += F.G) p2_decode_unit4(args, ws, u >> 3, u & 7, wid - 4, (LAS float*)(F.lds + LDSCTL_OFF + 1024), cntD, epoch);
    }
}

__global__ void __launch_bounds__(NWAVES * 64, 2) mk_fwd(Args args) {
    extern __shared__ __attribute__((aligned(16))) unsigned char lds[];
    Frame F;
    F.lds = (LAS unsigned char*)lds;
    F.MISC = (volatile LAS unsigned*)(F.lds + MISC_OFF);
    F.wave = __builtin_amdgcn_readfirstlane((int)threadIdx.x >> 6);
    F.G = gridDim.x; { const int bx = blockIdx.x; F.vcu = (F.G % 8 == 0) ? (bx % 8) * (F.G / 8) + bx / 8 : bx; }
    unsigned char* ws = args.ws;
    F.ctl = (gu32*)(ws + WS_CTL);
    for (int u = threadIdx.x; u < (LDS_BYTES - LDSCTL_OFF) / 4; u += NWAVES * 64) ((LAS unsigned*)(F.lds + LDSCTL_OFF))[u] = 0u;
    __syncthreads();
    const int lo = args.ph_lo, hi = args.ph_hi;
    const bool one = (hi - lo) > 1;
    XcdBarrier bar; bar.bar = (unsigned*)(F.ctl + CW_BAR); bar.x = 0; bar.st = nullptr;
    if (one) bar = xcd_barrier_post((unsigned*)(F.ctl + CW_BAR), F.MISC + 8);
#define IN(k) (lo <= (k) && (k) < hi)
#define BOTH(k) (IN(k) && IN((k) + 1))
#define GRID_BAR() xcd_barrier(bar)
    bf16* W1t = (bf16*)(ws + WS_W1); bf16* Wmt = (bf16*)(ws + WS_WM); bf16* Wot = (bf16*)(ws + WS_WO); bf16* Wgut = (bf16*)(ws + WS_WGU); bf16* Wdt = (bf16*)(ws + WS_WD);
    bf16* Hb = (bf16*)(ws + WS_H); bf16* Qb = (bf16*)(ws + WS_Q); bf16* Kb = (bf16*)(ws + WS_K); bf16* Vb = (bf16*)(ws + WS_V); bf16* BG = (bf16*)(ws + WS_BG); bf16* U = (bf16*)(ws + WS_U);
    bf16* G = (bf16*)(ws + WS_G); bf16* AM = (bf16*)(ws + WS_AM); bf16* Mb = (bf16*)(ws + WS_MB); bf16* X1b = (bf16*)(ws + WS_X1B); bf16* ACT = (bf16*)(ws + WS_ACT);
    float* rs1 = (float*)(F.ctl + CW_RS1); float* rs2 = (float*)(F.ctl + CW_RS2);
    pg8::RowMap RM{args.in[0], args.in[1], args.in[6], args.out + OFF_Y, (float*)(ws + WS_X1S)};

    if (IN(0)) { p0_prologue(F, args, ws); if (PROBE_DUP == 0) { GRID_BAR(); p0_prologue(F, args, ws); } if (BOTH(0)) GRID_BAR(); }
    if (IN(1)) {
        pg8::Gemm g{Hb, W1t, MMAIN, NIN, D}; pg8::StaticOrder S; S.init(MMAIN, NIN, F.G, (int)blockIdx.x);
        pg8::Epi1 E{Qb, Kb, Vb, BG, U, G, args.out};
        { const sm::EpiS1 ES{Qb, Kb, Vb, BG, U, G, args.out};
          for (int j = (int)blockIdx.x; j < 160; j += F.G) { int cA, cB; sm::job_cols(j, j >= 64, cA, cB); sm::small_job<3, false>(F.lds + RING_OFF, Hb + (size_t)MMAIN * D, D, W1t, cA, cB, MMAIN, ES); } }
        pg8::gemm_phase<pg8::Epi1, pg8::StaticOrder, true, true>(F.lds + RING_OFF, g, S, E);
        if (PROBE_DUP == 1) { GRID_BAR(); pg8::gemm_phase<pg8::Epi1, pg8::StaticOrder, true, true>(F.lds + RING_OFF, g, S, E); }
        if (BOTH(1)) GRID_BAR();
    }
    if (IN(2)) {
        unsigned p2_epoch = 0u; p2_all(F, args, ws, lds, p2_epoch);
        if (PROBE_DUP == 222) { GRID_BAR(); p2_all(F, args, ws, lds, p2_epoch); }
        if (BOTH(2)) GRID_BAR();
    }
    if (IN(3)) {
        pg8::Gemm g{AM, Wmt, MMAIN, D, D}; pg8::StaticOrder S; S.init(MMAIN, D, F.G, (int)blockIdx.x);
        pg8::Epi3 E{G, Mb};
        { const sm::EpiS3 ES{G, Mb};
          for (int j = (int)blockIdx.x; j < 32; j += F.G) { int cA, cB; sm::job_cols(j, false, cA, cB); sm::small_job<2, true>(F.lds + RING_OFF, AM + (size_t)ROW_SAMP * D, D, Wmt, cA, cB, ROW_SAMP, ES); } }
        pg8::gemm_phase<pg8::Epi3, pg8::StaticOrder, true, true>(F.lds + RING_OFF, g, S, E);
        if (PROBE_DUP == 3) { GRID_BAR(); pg8::gemm_phase<pg8::Epi3, pg8::StaticOrder, true, true>(F.lds + RING_OFF, g, S, E); }
        if (BOTH(3)) GRID_BAR();
    }
    if (IN(4)) {
        pg8::Gemm g{Mb, Wot, MMAIN, D, D}; pg8::StaticOrder S; S.init(MMAIN, D, F.G, (int)blockIdx.x);
        pg8::Epi4 E{RM, X1b, rs1};
        { const sm::EpiS4 ES{RM, X1b, rs1};
          for (int j = (int)blockIdx.x; j < 32; j += F.G) { int cA, cB; sm::job_cols(j, false, cA, cB); sm::small_job<2, false>(F.lds + RING_OFF, Mb + (size_t)ROW_SAMP * D, D, Wot, cA, cB, ROW_SAMP, ES); } }
        pg8::gemm_phase<pg8::Epi4, pg8::StaticOrder, true, true>(F.lds + RING_OFF, g, S, E);
        if (BOTH(4)) GRID_BAR();
    }
    if (IN(5)) {
        pg8::Gemm g{X1b, Wgut, MMAIN, NGU, D}; pg8::StaticOrder S; S.init(MMAIN, NGU, F.G, (int)blockIdx.x);
        pg8::Epi5 E{rs1, ACT};
        { const sm::EpiS5 ES{rs1, ACT};
          for (int j = (F.G == 256 ? ((int)blockIdx.x + 128) & 255 : (int)blockIdx.x); j < 176; j += (F.G == 256 ? 128 : F.G)) { if (F.G == 256 && (int)blockIdx.x < 128) break; int cA, cB; sm::job_cols(j, true, cA, cB);     sm::small_job<2, false>(F.lds + RING_OFF, X1b + (size_t)ROW_SAMP * D, D, Wgut, cA, cB, ROW_SAMP, ES); } }
        pg8::gemm_phase<pg8::Epi5, pg8::StaticOrder, true, true>(F.lds + RING_OFF, g, S, E);
        if (PROBE_DUP == 5) { GRID_BAR(); pg8::gemm_phase<pg8::Epi5, pg8::StaticOrder, true, true>(F.lds + RING_OFF, g, S, E); }
        if (BOTH(5)) GRID_BAR();
    }
    if (IN(6)) {
        pg8::Gemm g{ACT, Wdt, MMAIN, D, FF}; pg8::StaticOrder S; S.init(MMAIN, D, F.G, (int)blockIdx.x);
        pg8::Epi6 E{X1b, Mb, rs2};
        { const sm::EpiS6 ES{RM, rs2};
          for (int j = (int)blockIdx.x; j < 32; j += F.G) { int cA, cB; sm::job_cols(j, false, cA, cB); sm::small_job<2, false>(F.lds + RING_OFF, ACT + (size_t)ROW_SAMP * FF, FF, Wdt, cA, cB, ROW_SAMP, ES); } }
        pg8::gemm_phase<pg8::Epi6, pg8::StaticOrder, true, true>(F.lds + RING_OFF, g, S, E);
        if (BOTH(6)) GRID_BAR();
    }
    if (IN(7)) { p7_final(F, args, ws); }
#undef IN
#undef BOTH
#undef GRID_BAR
}

extern "C" void kernel_launch(void* const* d_in, const int* in_sizes, int n_in, void* d_out, int out_size, void* d_ws, size_t ws_size, hipStream_t stream) {
    static int grid = 0;
    if (grid == 0) {
        if (n_in != 19 || out_size != (int)OUT_TOTAL || ws_size < WS_END) { fprintf(stderr, "kernel_launch: unexpected shapes: n_in %d out %d ws %zu\n", n_in, out_size, ws_size); grid = -1; return; }
        int dev = 0, cus = 0, per_cu = 0;
        if (hipGetDevice(&dev) != hipSuccess || hipDeviceGetAttribute(&cus, hipDeviceAttributeMultiprocessorCount, dev) != hipSuccess) { grid = -1; return; }
        if (hipFuncSetAttribute((const void*)mk_fwd, hipFuncAttributeMaxDynamicSharedMemorySize, LDS_BYTES) != hipSuccess) { fprintf(stderr, "kernel_launch: hipFuncSetAttribute failed\n"); grid = -1; return; }
        if (hipOccupancyMaxActiveBlocksPerMultiprocessor(&per_cu, (const void*)mk_fwd, NWAVES * 64, LDS_BYTES) != hipSuccess || per_cu < 1) fprintf(stderr, "kernel_launch: occupancy query reports %d per CU\n", per_cu);
        (void)hipGetLastError();
        grid = cus;
    }
    if (grid < 0) return;
    if (hipMemsetAsync((char*)d_ws + WS_CTL, 0, CTL_ZERO_BYTES, stream) != hipSuccess) return;
    Args a{};
    for (int i = 0; i < 19; ++i) a.in[i] = (const float*)d_in[i];
    a.out = (float*)d_out; a.ws = (unsigned char*)d_ws;
#if MK_ONE_LAUNCH
    a.ph_lo = 0; a.ph_hi = N_PHASES;
    hipLaunchKernelGGL(mk_fwd, dim3(grid), dim3(NWAVES * 64), LDS_BYTES, stream, a);
#else
    for (int p = 0; p < N_PHASES; ++p) { a.ph_lo = p; a.ph_hi = p + 1; hipLaunchKernelGGL(mk_fwd, dim3(grid), dim3(NWAVES * 64), LDS_BYTES, stream, a); }
#endif
}
```

```cpp
#include <hip/hip_runtime.h>
#include <hip/hip_bf16.h>
#include <cstdio>
#include <cstdint>
#include <type_traits>
__device__ __forceinline__ int tid_now() { int t = threadIdx.x; asm volatile("" : "+v"(t)); return t; }

constexpr int D = 1024, NBATCH = 8, TSEQ = 2048, NMETA = 16, NSAMP = 32, NHEAD = 8, HDIM = 64, DATT = 512, DCONV = 512, FF = 2816;
constexpr int MMAIN = NBATCH * TSEQ;
constexpr int ROW_META = MMAIN;
constexpr int ROW_SAMP = MMAIN + NMETA;
constexpr int ROW_END = ROW_SAMP + NSAMP;
constexpr int M_TOT = 16640;
constexpr int NIN = 5120, NGU = 2 * FF;
constexpr int KPAD = 2112;
constexpr int LSEQ = NMETA + TSEQ;
constexpr int PAST = 8192, PAGE = 128, NPAGES = 64;
constexpr float EPS = 1e-6f;
constexpr float LOG2E = 1.4426950408889634f;
constexpr float C2 = 0.125f * LOG2E;
constexpr size_t OFF_Y = 0, OFF_YS = 16777216, OFF_KP = 16809984, OFF_VP = 25264128, OFF_CP = 33718272, OFF_KS = 33726464, OFF_VS = 33742848, OFF_CS = 33759232, OUT_TOTAL = 33792000;

namespace pg8 {
#define PG8_LAS __attribute__((address_space(3)))
typedef unsigned short bf16_t;
typedef short bf16x8 __attribute__((ext_vector_type(8)));
typedef float f32x4 __attribute__((ext_vector_type(4)));
typedef unsigned u32x4 __attribute__((ext_vector_type(4)));
constexpr int BM = 256, BK = 64, HALF = 128, HTB = HALF * BK * 2  , STAGE_BYTES = 8 * HTB, NXCD = 8, WGM = 8;

__host__ __device__ __forceinline__ int lds_byte(int r, int c) { const int st = (r >> 4) * 2 + (c >> 5), rr = r & 15, cc = c & 31, ob = rr * 64 + cc * 2; return st * 1024 + (ob ^ (((ob >> 9) & 1) << 5)); }
__host__ __device__ __forceinline__ void stage_rc(int b, int& R, int& C) { const int st = b / 1024, sb = b % 1024, swz = sb ^ (((sb >> 9) & 1) << 5); R = (st >> 1) * 16 + swz / 64; C = (st & 1) * 32 + (swz % 64) / 2; }
__host__ __device__ __forceinline__ int perm32(int rho) { const int n = rho >> 4, i = rho & 15; return 8 * (i >> 2) + 4 * n + (i & 3); }

struct Unit { int pm, pn; };
struct Gemm { const bf16_t* A; const bf16_t* Bt; int M, N, K; };

struct StaticOrder {
    int nM, nN, nwg, G, c;
    __host__ __device__ void init(int M, int N, int G_, int c_) { nM = M / BM; nN = N / BM; nwg = nM * nN; G = G_; c = c_; }
    __host__ __device__ bool next(int i, Unit& u) const {
        const long L = (long)i * G + c; if (L >= nwg) return false;
        int wgid = (int)L; { const int q = nwg / NXCD, r = nwg % NXCD, xcd = wgid % NXCD, off = wgid / NXCD; wgid = (xcd < r ? xcd * (q + 1) : r * (q + 1) + (xcd - r) * q) + off; }
        const int nig = WGM * nN, gid = wgid / nig, fm = gid * WGM, gsz = (nM - fm) < WGM ? (nM - fm) : WGM;
        u.pm = fm + ((wgid % nig) % gsz); u.pn = (wgid % nig) / gsz; return true;
    }
    __device__ __forceinline__ void a_ready(const Unit&) const {}
    __device__ __forceinline__ void done(const Unit&) const {}
};

__device__ __forceinline__ unsigned cvt_pk_bf16(float lo, float hi) { unsigned r; asm volatile("v_cvt_pk_bf16_f32 %0, %1, %2" : "=v"(r) : "v"(lo), "v"(hi)); return r; }
typedef float f32x2 __attribute__((ext_vector_type(2)));
__device__ __forceinline__ u32x4 pack8(const f32x4 a, const f32x4 b) { u32x4 w; w.x = cvt_pk_bf16(a[0], a[1]); w.y = cvt_pk_bf16(a[2], a[3]); w.z = cvt_pk_bf16(b[0], b[1]); w.w = cvt_pk_bf16(b[2], b[3]); return w; }
__device__ __forceinline__ float bf_lo(unsigned w) { return __builtin_bit_cast(float, w << 16); }
__device__ __forceinline__ float bf_hi(unsigned w) { return __builtin_bit_cast(float, w & 0xffff0000u); }
__device__ __forceinline__ void unpack8(const u32x4 w, f32x4& a, f32x4& b) { a = (f32x4){bf_lo(w.x), bf_hi(w.x), bf_lo(w.y), bf_hi(w.y)}; b = (f32x4){bf_lo(w.z), bf_hi(w.z), bf_lo(w.w), bf_hi(w.w)}; }

struct Epi1 {
    static constexpr bool PERM = true, AFTER_DRAIN = false, HAS_MID = false;
    bf16_t *Qb, *Kb, *Vb, *BG, *U, *G; float* out;
    __device__ __forceinline__ void mid(f32x4 (&acc)[2][2][4][2], const Unit& u, int wr, int wc, int fr, int fq) const {}
    __device__ __forceinline__ void operator()(const f32x4 (&acc)[2][2][4][2], const Unit& u, int wr, int wc, int fr, int fq) const {
        const int pn = u.pn, cc = wc * 32 + 8 * fq;
#pragma unroll
        for (int ai = 0; ai < 2; ++ai)
#pragma unroll
            for (int m = 0; m < 4; ++m) {
                const int row = u.pm * BM + ai * HALF + wr * 64 + m * 16 + fr;
                if (pn < 2) {
#pragma unroll
                    for (int bj = 0; bj < 2; ++bj) *(u32x4*)(Qb + (size_t)row * DATT + pn * 256 + bj * HALF + cc) = pack8(acc[ai][bj][m][0] * C2, acc[ai][bj][m][1] * C2);
                } else if (pn < 6) {
                    const bool isv = pn >= 4; bf16_t* KV = isv ? Vb : Kb; float* outp = out + (isv ? OFF_VP : OFF_KP); float* outs = out + (isv ? OFF_VS : OFF_KS);
#pragma unroll
                    for (int bj = 0; bj < 2; ++bj) { const int col = (pn & 1) * 256 + bj * HALF + cc; const f32x4 v0 = acc[ai][bj][m][0], v1 = acc[ai][bj][m][1]; const u32x4 w = pack8(v0, v1);
                        if (row < MMAIN) { const int b = row >> 11, t = row & 2047; *(u32x4*)(KV + (size_t)(b * KPAD + 64 + t) * DATT + col) = w;
                            float* o = outp + (size_t)(b * LSEQ + NMETA + t) * DATT + col; *(f32x4*)o = v0; *(f32x4*)(o + 4) = v1; }
                        else if (row < ROW_SAMP) { const int i = row - ROW_META;
                            for (int b = 0; b < NBATCH; ++b) { *(u32x4*)(KV + (size_t)(b * KPAD + 48 + i) * DATT + col) = w; float* o = outp + (size_t)(b * LSEQ + i) * DATT + col; *(f32x4*)o = v0; *(f32x4*)(o + 4) = v1; } }
                        else if (row < ROW_END) { float* o = outs + (size_t)(row - ROW_SAMP) * DATT + col; *(f32x4*)o = v0; *(f32x4*)(o + 4) = v1; } }
                } else if (pn < 8) {
#pragma unroll
                    for (int bj = 0; bj < 2; ++bj) *(u32x4*)(BG + (size_t)row * DCONV + (pn - 6) * 256 + bj * HALF + cc) = pack8(acc[ai][bj][m][0], acc[ai][bj][m][1]);
                } else if (pn < 12) {
                    const int ch = (pn - 8) * HALF + cc; const f32x4 u0 = acc[ai][0][m][0] * acc[ai][1][m][0], u1 = acc[ai][0][m][1] * acc[ai][1][m][1];
                    *(u32x4*)(U + (size_t)row * DCONV + ch) = pack8(u0, u1);
                    if (row < MMAIN) { const int t = row & 2047; if (t >= TSEQ - 2) { float* o = out + OFF_CP + (size_t)((row >> 11) * 2 + (t - (TSEQ - 2))) * DCONV + ch; *(f32x4*)o = u0; *(f32x4*)(o + 4) = u1; } }
                    else if (row >= ROW_SAMP && row < ROW_END) { float* o = out + OFF_CS + (size_t)((row - ROW_SAMP) * 2 + 1) * DCONV + ch; *(f32x4*)o = u0; *(f32x4*)(o + 4) = u1; }
                } else {
                    const int ch = (pn - 12) * HALF + cc; f32x4 r[2], s[2];
#pragma unroll
                    for (int n = 0; n < 2; ++n)
#pragma unroll
                        for (int e = 0; e < 4; ++e) { const float ga = fminf(fmaxf(acc[ai][0][m][n][e], -30.f), 30.f), gb = fminf(fmaxf(acc[ai][1][m][n][e], -30.f), 30.f);
                            const float ea = __builtin_amdgcn_exp2f(-ga * LOG2E), eb = __builtin_amdgcn_exp2f(-gb * LOG2E); const float ia = __builtin_amdgcn_rcpf(1.f + ea), ib = __builtin_amdgcn_rcpf(1.f + eb);
                            r[n][e] = (1.f + eb) * ia; s[n][e] = ib; }
                    *(u32x4*)(G + (size_t)row * 2048 + ch) = pack8(r[0], r[1]); *(u32x4*)(G + (size_t)row * 2048 + 1024 + ch) = pack8(s[0], s[1]);
                }
            }
    }
};
struct Epi3 {
    static constexpr bool PERM = true, AFTER_DRAIN = false, HAS_MID = true;
    const bf16_t* G; bf16_t* Mb;
    __device__ __forceinline__ void mid(f32x4 (&acc)[2][2][4][2], const Unit& u, int wr, int wc, int fr, int fq) const {
#pragma unroll
        for (int ai = 0; ai < 2; ++ai)
#pragma unroll
            for (int m = 0; m < 4; ++m) { const int row = u.pm * BM + ai * HALF + wr * 64 + m * 16 + fr;
#pragma unroll
                for (int bj = 0; bj < 2; ++bj) { const int col = u.pn * BM + bj * HALF + wc * 32 + 8 * fq; f32x4 a, b; unpack8(*(const u32x4*)(G + (size_t)row * 2048 + col), a, b);
                    acc[ai][bj][m][0] *= a; acc[ai][bj][m][1] *= b; } }
    }
    __device__ __forceinline__ void operator()(const f32x4 (&acc)[2][2][4][2], const Unit& u, int wr, int wc, int fr, int fq) const {
#pragma unroll
        for (int ai = 0; ai < 2; ++ai)
#pragma unroll
            for (int m = 0; m < 4; ++m) { const int row = u.pm * BM + ai * HALF + wr * 64 + m * 16 + fr;
#pragma unroll
                for (int bj = 0; bj < 2; ++bj) { const int col = u.pn * BM + bj * HALF + wc * 32 + 8 * fq; f32x4 a, b; unpack8(*(const u32x4*)(G + (size_t)row * 2048 + 1024 + col), a, b);
                    *(u32x4*)(Mb + (size_t)row * D + col) = pack8(acc[ai][bj][m][0] * a, acc[ai][bj][m][1] * b); } }
    }
};
struct RowMap {
    const float *xp, *xs, *meta; float *y, *x1s;
    __device__ __forceinline__ const float* xin(int row) const { return row < MMAIN ? xp + (size_t)row * D : row < ROW_SAMP ? meta + (size_t)(row - ROW_META) * D : row < ROW_END ? xs + (size_t)(row - ROW_SAMP) * D : nullptr; }
    __device__ __forceinline__ float* x1(int row) const { return row < MMAIN ? y + (size_t)row * D : x1s + (size_t)(row - MMAIN) * D; }
};
struct Epi4 {
    static constexpr bool PERM = true, AFTER_DRAIN = false, HAS_MID = false;
    RowMap R; bf16_t* X1b; float* rowsum;
    __device__ __forceinline__ void mid(f32x4 (&acc)[2][2][4][2], const Unit& u, int wr, int wc, int fr, int fq) const {}
    __device__ __forceinline__ void operator()(const f32x4 (&acc)[2][2][4][2], const Unit& u, int wr, int wc, int fr, int fq) const {
#pragma unroll
        for (int ai = 0; ai < 2; ++ai)
#pragma unroll
            for (int m = 0; m < 4; ++m) { const int row = u.pm * BM + ai * HALF + wr * 64 + m * 16 + fr; const float* xi = R.xp + (size_t)row * D; float ss = 0.f;
#pragma unroll
                for (int bj = 0; bj < 2; ++bj) { const int col = u.pn * BM + bj * HALF + wc * 32 + 8 * fq;
                    f32x4 a = *(const f32x4*)(xi + col), b = *(const f32x4*)(xi + col + 4);
                    a += acc[ai][bj][m][0]; b += acc[ai][bj][m][1];
                    *(u32x4*)(X1b + (size_t)row * D + col) = pack8(a, b);
                    ss += (a[0] * a[0] + a[1] * a[1]) + (a[2] * a[2] + a[3] * a[3]) + (b[0] * b[0] + b[1] * b[1]) + (b[2] * b[2] + b[3] * b[3]); }
                ss += __shfl_xor(ss, 16); ss += __shfl_xor(ss, 32);
                if (fq == 0) unsafeAtomicAdd(rowsum + row, ss); }
    }
};
struct Epi5 {
    static constexpr bool PERM = true, AFTER_DRAIN = false, HAS_MID = false;
    const float* rowsum; bf16_t* ACT;
    __device__ __forceinline__ void mid(f32x4 (&acc)[2][2][4][2], const Unit& u, int wr, int wc, int fr, int fq) const {}
    __device__ __forceinline__ void operator()(const f32x4 (&acc)[2][2][4][2], const Unit& u, int wr, int wc, int fr, int fq) const {
#pragma unroll
        for (int ai = 0; ai < 2; ++ai)
#pragma unroll
            for (int m = 0; m < 4; ++m) { const int row = u.pm * BM + ai * HALF + wr * 64 + m * 16 + fr; const float rstd = __builtin_amdgcn_rsqf(rowsum[row] * (1.0f / D) + EPS); f32x4 o[2];
#pragma unroll
                for (int n = 0; n < 2; ++n)
#pragma unroll
                    for (int e = 0; e < 4; ++e) { const float g = acc[ai][0][m][n][e] * rstd, up = acc[ai][1][m][n][e] * rstd; const float eg = __builtin_amdgcn_exp2f(-g * LOG2E);
                        o[n][e] = g * __builtin_amdgcn_rcpf(1.f + eg) * up; }
                *(u32x4*)(ACT + (size_t)row * FF + u.pn * HALF + wc * 32 + 8 * fq) = pack8(o[0], o[1]); }
    }
};
struct Epi6 {
    static constexpr bool PERM = true, AFTER_DRAIN = false, HAS_MID = false;
    const bf16_t* X1b; bf16_t* X2b; float* rowsum;
    __device__ __forceinline__ void mid(f32x4 (&acc)[2][2][4][2], const Unit& u, int wr, int wc, int fr, int fq) const {}
    __device__ __forceinline__ void operator()(const f32x4 (&acc)[2][2][4][2], const Unit& u, int wr, int wc, int fr, int fq) const {
#pragma unroll
        for (int ai = 0; ai < 2; ++ai)
#pragma unroll
            for (int m = 0; m < 4; ++m) { const int row = u.pm * BM + ai * HALF + wr * 64 + m * 16 + fr; float ss = 0.f;
#pragma unroll
                for (int bj = 0; bj < 2; ++bj) { const int col = u.pn * BM + bj * HALF + wc * 32 + 8 * fq;
                    f32x4 a, b; unpack8(*(const u32x4*)(X1b + (size_t)row * D + col), a, b);
                    a += acc[ai][bj][m][0]; b += acc[ai][bj][m][1];
                    *(u32x4*)(X2b + (size_t)row * D + col) = pack8(a, b);
                    ss += (a[0] * a[0] + a[1] * a[1]) + (a[2] * a[2] + a[3] * a[3]) + (b[0] * b[0] + b[1] * b[1]) + (b[2] * b[2] + b[3] * b[3]); }
                ss += __shfl_xor(ss, 16); ss += __shfl_xor(ss, 32);
                if (fq == 0) unsafeAtomicAdd(rowsum + row, ss); }
    }
};

template <class Epi, class Sched, bool ALIGN_EPI = false, bool SP2 = false>
__device__ __forceinline__ void gemm_phase(PG8_LAS unsigned char* lds, const Gemm g, const Sched& S, const Epi& E) {
    const int tid = tid_now(), wid = __builtin_amdgcn_readfirstlane(tid >> 6), lane = tid & 63, wr = wid >> 2, wc = wid & 3, fr = lane & 15, fq = lane >> 4;
    const int K = g.K, nt = K / BK;
    unsigned voffA[2], voffB[2];
#pragma unroll
    for (int i = 0; i < 2; ++i) { int R, C; stage_rc(tid * 16 + i * 8192, R, C); const int Rb = Epi::PERM ? ((R & ~31) + perm32(R & 31)) : R;
        voffA[i] = (unsigned)(R * K + C) * 2u; voffB[i] = (unsigned)(Rb * K + C) * 2u; }
    const size_t kstep = (size_t)(BK * 2);
    const size_t hstep = (size_t)HALF * K * 2;
    const size_t tstep = 2 * hstep;
    const unsigned ldsw = (unsigned)wid * 1024u;
    const int aoff = lds_byte(wr * 64 + fr, fq * 8), boff = lds_byte(wc * 32 + fr, fq * 8);
#define PG8_SA(b, h) (((b) * 2 + (h)) * HTB)
#define PG8_SB(b, h) ((4 + (b) * 2 + (h)) * HTB)
#define PG8_STAGE(bufoff, gbase, voff) do { _Pragma("unroll") for (int _i = 0; _i < 2; ++_i) \
        __builtin_amdgcn_global_load_lds((const unsigned*)((const char*)(gbase) + (voff)[_i]), (PG8_LAS unsigned*)(lds + (bufoff) + ldsw + _i * 8192), 16, 0, 0); } while (0)
#define PG8_LDA(dst, b, h) do { _Pragma("unroll") for (int m = 0; m < 4; ++m) _Pragma("unroll") for (int k = 0; k < 2; ++k) dst[m][k] = *(const PG8_LAS bf16x8*)(lds + PG8_SA(b, h) + aoff + m * 2048 + k * 1024); } while (0)
#define PG8_LDB(dst, b, h) do { _Pragma("unroll") for (int n = 0; n < 2; ++n) _Pragma("unroll") for (int k = 0; k < 2; ++k) dst[n][k] = *(const PG8_LAS bf16x8*)(lds + PG8_SB(b, h) + boff + n * 2048 + k * 1024); } while (0)
#define PG8_MMA(ai, bj, At, Bt) do { __builtin_amdgcn_s_setprio(1); _Pragma("unroll") for (int m = 0; m < 4; ++m) _Pragma("unroll") for (int n = 0; n < 2; ++n) _Pragma("unroll") for (int k = 0; k < 2; ++k) \
        acc[ai][bj][m][n] = __builtin_amdgcn_mfma_f32_16x16x32_bf16(Bt[n][k], At[m][k], acc[ai][bj][m][n], 0, 0, 0); __builtin_amdgcn_s_setprio(0); } while (0)
#define PG8_WAIT_V(n) asm volatile("s_waitcnt vmcnt(" #n ")" ::: "memory")
#define PG8_WAIT_L(n) asm volatile("s_waitcnt lgkmcnt(" #n ")" ::: "memory")
#define PG8_BAR __builtin_amdgcn_s_barrier()
#define PG8_SCHED __builtin_amdgcn_sched_barrier(0)
    Unit cur, nxt; int ui = 0;
    if (!S.next(0, cur)) return;
    f32x4 acc[2][2][4][2];
#pragma unroll
    for (int a = 0; a < 2; ++a)
#pragma unroll
        for (int b = 0; b < 2; ++b)
#pragma unroll
            for (int m = 0; m < 4; ++m)
#pragma unroll
                for (int n = 0; n < 2; ++n) acc[a][b][m][n] = (f32x4){0.f, 0.f, 0.f, 0.f};
    bf16x8 At[4][2], B0[2][2], B1[2][2];
    const char* cA = (const char*)g.A + (size_t)cur.pm * tstep; const char* cB = (const char*)g.Bt + (size_t)cur.pn * tstep;
    S.a_ready(cur);
    if constexpr (SP2) {
        PG8_STAGE(PG8_SB(0, 0), cB, voffB); PG8_STAGE(PG8_SB(0, 1), cB + hstep, voffB); PG8_STAGE(PG8_SA(0, 0), cA, voffA); PG8_STAGE(PG8_SA(0, 1), cA + hstep, voffA);
        if (wr == 1) PG8_BAR;
        PG8_WAIT_V(2); PG8_BAR;
        PG8_STAGE(PG8_SB(1, 0), cB + kstep, voffB); PG8_STAGE(PG8_SA(1, 0), cA + kstep, voffA); PG8_STAGE(PG8_SB(1, 1), cB + hstep + kstep, voffB);
        PG8_WAIT_V(6); PG8_BAR;
    } else {
        PG8_STAGE(PG8_SB(0, 0), cB, voffB); PG8_STAGE(PG8_SA(0, 0), cA, voffA); PG8_STAGE(PG8_SB(0, 1), cB + hstep, voffB); PG8_STAGE(PG8_SA(0, 1), cA + hstep, voffA);
        if (wr == 1) PG8_BAR;
        PG8_WAIT_V(4); PG8_BAR;
        PG8_STAGE(PG8_SB(1, 0), cB + kstep, voffB); PG8_STAGE(PG8_SA(1, 0), cA + kstep, voffA); PG8_STAGE(PG8_SB(1, 1), cB + hstep + kstep, voffB);
        PG8_WAIT_V(6); PG8_BAR;
    }
    for (;;) {
        const bool has_next = S.next(ui + 1, nxt);
        const char* nA = has_next ? (const char*)g.A + (size_t)nxt.pm * tstep : cA; const char* nB = has_next ? (const char*)g.Bt + (size_t)nxt.pn * tstep : cB;
        for (int t = 0; t < nt; t += 2) {
            if constexpr (Epi::HAS_MID) { if (t == (nt >> 1)) E.mid(acc, cur, wr, wc, fr, fq); }
            const bool last = (t == nt - 2);
            const char* a1 = cA + (size_t)(t + 1) * kstep;
            const char* a2 = last ? nA : cA + (size_t)(t + 2) * kstep; const char* b2 = last ? nB : cB + (size_t)(t + 2) * kstep;
            const char* a3 = a2 + kstep; const char* b3 = b2 + kstep;
            if (last && has_next) S.a_ready(nxt);
            if constexpr (SP2) {
            PG8_LDB(B0, 0, 0); PG8_LDB(B1, 0, 1); PG8_SCHED; PG8_LDA(At, 0, 0); PG8_STAGE(PG8_SA(1, 1), a1 + hstep, voffA);
            PG8_WAIT_V(8); PG8_WAIT_L(0); PG8_BAR; PG8_MMA(0, 0, At, B0); PG8_MMA(0, 1, At, B1); PG8_BAR; PG8_SCHED;
            PG8_LDA(At, 0, 1); PG8_STAGE(PG8_SB(0, 0), b2, voffB); PG8_STAGE(PG8_SB(0, 1), b2 + hstep, voffB); PG8_STAGE(PG8_SA(0, 0), a2, voffA);
            PG8_WAIT_V(8); PG8_WAIT_L(0); PG8_BAR; PG8_MMA(1, 0, At, B0); PG8_MMA(1, 1, At, B1); PG8_BAR; PG8_SCHED;
            PG8_LDB(B0, 1, 0); PG8_LDB(B1, 1, 1); PG8_SCHED; PG8_LDA(At, 1, 0); PG8_STAGE(PG8_SA(0, 1), a2 + hstep, voffA);
            PG8_WAIT_V(8); PG8_WAIT_L(0); PG8_BAR; PG8_MMA(0, 0, At, B0); PG8_MMA(0, 1, At, B1); PG8_BAR; PG8_SCHED;
            PG8_LDA(At, 1, 1); PG8_STAGE(PG8_SB(1, 0), b3, voffB); PG8_STAGE(PG8_SB(1, 1), b3 + hstep, voffB); PG8_STAGE(PG8_SA(1, 0), a3, voffA);
            PG8_WAIT_V(8); PG8_WAIT_L(0); PG8_BAR; PG8_MMA(1, 0, At, B0); PG8_MMA(1, 1, At, B1); PG8_BAR; PG8_SCHED;
            } else {
            PG8_LDB(B0, 0, 0); PG8_SCHED; PG8_LDA(At, 0, 0); PG8_STAGE(PG8_SA(1, 1), a1 + hstep, voffA);
            PG8_WAIT_L(8); PG8_BAR; PG8_WAIT_L(0); PG8_MMA(0, 0, At, B0); PG8_BAR; PG8_SCHED;
            PG8_LDB(B1, 0, 1); PG8_STAGE(PG8_SB(0, 0), b2, voffB);
            PG8_BAR; PG8_WAIT_L(0); PG8_MMA(0, 1, At, B1); PG8_BAR;
            PG8_LDA(At, 0, 1); PG8_STAGE(PG8_SA(0, 0), a2, voffA);
            PG8_BAR; PG8_WAIT_L(0); PG8_MMA(1, 0, At, B0); PG8_BAR; PG8_SCHED;
            PG8_STAGE(PG8_SB(0, 1), b2 + hstep, voffB);
            PG8_WAIT_V(6); PG8_BAR; PG8_MMA(1, 1, At, B1); PG8_BAR;
            PG8_LDB(B0, 1, 0); PG8_SCHED; PG8_LDA(At, 1, 0); PG8_STAGE(PG8_SA(0, 1), a2 + hstep, voffA);
            PG8_WAIT_L(8); PG8_BAR; PG8_WAIT_L(0); PG8_MMA(0, 0, At, B0); PG8_BAR; PG8_SCHED;
            PG8_LDB(B1, 1, 1); PG8_STAGE(PG8_SB(1, 0), b3, voffB);
            PG8_BAR; PG8_WAIT_L(0); PG8_MMA(0, 1, At, B1); PG8_BAR;
            PG8_LDA(At, 1, 1); PG8_STAGE(PG8_SA(1, 0), a3, voffA);
            PG8_BAR; PG8_WAIT_L(0); PG8_MMA(1, 0, At, B0); PG8_BAR; PG8_SCHED;
            PG8_STAGE(PG8_SB(1, 1), b3 + hstep, voffB);
            PG8_WAIT_V(6); PG8_BAR; PG8_MMA(1, 1, At, B1); PG8_BAR;
            }
        }
        if constexpr (ALIGN_EPI) { if (wr == 0) PG8_BAR; }
        if constexpr (!Epi::AFTER_DRAIN) { E(acc, cur, wr, wc, fr, fq); S.done(cur); }
        if (!has_next) break;
#pragma unroll
        for (int a = 0; a < 2; ++a)
#pragma unroll
            for (int b = 0; b < 2; ++b)
#pragma unroll
                for (int m = 0; m < 4; ++m)
#pragma unroll
                    for (int n = 0; n < 2; ++n) acc[a][b][m][n] = (f32x4){0.f, 0.f, 0.f, 0.f};
        cur = nxt; cA = nA; cB = nB; ++ui;
        if constexpr (ALIGN_EPI) { if (wr == 1) PG8_BAR; }
    }
    PG8_WAIT_V(0);
    if constexpr (!ALIGN_EPI) { if (wr == 0) PG8_BAR; }
    PG8_BAR;
    if constexpr (Epi::AFTER_DRAIN) { E.fused(acc, cur, wr, wc, fr, fq, lds, wid, lane); S.done(cur); }
#undef PG8_SA
#undef PG8_SB
#undef PG8_STAGE
#undef PG8_LDA
#undef PG8_LDB
#undef PG8_MMA
#undef PG8_WAIT_V
#undef PG8_WAIT_L
#undef PG8_BAR
#undef PG8_SCHED
}
}

namespace sbattn {
using bf16x8 = __attribute__((ext_vector_type(8))) short;
using s16x4 = __attribute__((ext_vector_type(4))) short;
using f32x16 = __attribute__((ext_vector_type(16))) float;
using u32x4 = __attribute__((ext_vector_type(4))) unsigned;
typedef _Float16 f16x8 __attribute__((ext_vector_type(8)));
typedef __attribute__((address_space(3))) const char* lds_cptr;
constexpr int SLOTB = 8192;
constexpr int NSLOT = 6, PD = NSLOT - 1;
constexpr int LDS_K = 0, LDS_V = NSLOT * SLOTB, LDS_Q = 2 * NSLOT * SLOTB, LDS_OST = LDS_Q + 4 * 4096, LDS_BYTES = LDS_OST + 4 * 4096;
__device__ __forceinline__ int crow(int r, int hi) { return (r & 3) + 8 * (r >> 2) + 4 * hi; }
__device__ __forceinline__ void glds16(const void* gsrc, unsigned lds_dst) { unsigned keep;
    asm volatile("s_mov_b32 %0, m0\n\ts_mov_b32 m0, %2\n\ts_nop 0\n\tglobal_load_lds_dwordx4 %1, off\n\ts_mov_b32 m0, %0" : "=&s"(keep) : "v"(gsrc), "s"(lds_dst) : "memory"); }
typedef float f32x2_t __attribute__((ext_vector_type(2))); typedef __bf16 bf16x2_t __attribute__((ext_vector_type(2)));
__device__ __forceinline__ unsigned cvtpk(float lo, float hi) { f32x2_t v = {lo, hi}; bf16x2_t b = __builtin_convertvector(v, bf16x2_t); return __builtin_bit_cast(unsigned, b); }
__device__ __forceinline__ void qkt(f32x16& p0, f32x16& p1, lds_cptr Kslot, const bf16x8* qr, const f32x16& c0, int r32, int hi) {
    lds_cptr kb = Kslot + hi * 1024 + r32 * 16;
#pragma unroll
    for (int d0 = 0; d0 < 4; ++d0) {
        const bf16x8 b0 = *(const __attribute__((address_space(3))) bf16x8*)(kb + d0 * 2048);
        const bf16x8 b1 = *(const __attribute__((address_space(3))) bf16x8*)(kb + d0 * 2048 + 512);
        if (d0 == 0) { p0 = __builtin_amdgcn_mfma_f32_32x32x16_bf16(b0, qr[0], c0, 0, 0, 0); p1 = __builtin_amdgcn_mfma_f32_32x32x16_bf16(b1, qr[0], c0, 0, 0, 0); }
        else { p0 = __builtin_amdgcn_mfma_f32_32x32x16_bf16(b0, qr[d0], p0, 0, 0, 0); p1 = __builtin_amdgcn_mfma_f32_32x32x16_bf16(b1, qr[d0], p1, 0, 0, 0); } }
}
__device__ __forceinline__ void pv(f32x16* o, int vb, bf16x8 pa0, bf16x8 pa1, bf16x8 pa2, bf16x8 pa3) {
#pragma unroll
    for (int d0 = 0; d0 < 2; ++d0) { s16x4 lo[4], hi[4];
#pragma unroll
        for (int ks = 0; ks < 4; ++ks) {
            asm volatile("ds_read_b64_tr_b16 %0,%1 offset:%c2" : "=&v"(lo[ks]) : "v"(vb), "i"(d0 * 4096 + ks * 1024) : "memory");
            asm volatile("ds_read_b64_tr_b16 %0,%1 offset:%c2" : "=&v"(hi[ks]) : "v"(vb), "i"(d0 * 4096 + ks * 1024 + 512) : "memory"); }
        asm volatile("s_waitcnt lgkmcnt(0)" ::: "memory"); __builtin_amdgcn_sched_barrier(0);
#define SB_PK(k) (bf16x8){lo[k][0], lo[k][1], lo[k][2], lo[k][3], hi[k][0], hi[k][1], hi[k][2], hi[k][3]}
        o[d0] = __builtin_amdgcn_mfma_f32_32x32x16_bf16(pa0, SB_PK(0), o[d0], 0, 0, 0);
        o[d0] = __builtin_amdgcn_mfma_f32_32x32x16_bf16(pa1, SB_PK(1), o[d0], 0, 0, 0);
        o[d0] = __builtin_amdgcn_mfma_f32_32x32x16_bf16(pa2, SB_PK(2), o[d0], 0, 0, 0);
        o[d0] = __builtin_amdgcn_mfma_f32_32x32x16_bf16(pa3, SB_PK(3), o[d0], 0, 0, 0);
#undef SB_PK
    }
}
__device__ __forceinline__ f16x8 l8(const f32x16& l, int b) { return (f16x8){(_Float16)l[b], (_Float16)l[b + 1], (_Float16)l[b + 2], (_Float16)l[b + 3], (_Float16)l[b + 4], (_Float16)l[b + 5], (_Float16)l[b + 6], (_Float16)l[b + 7]}; }
__device__ __forceinline__ void grp_arrive_wait(__attribute__((address_space(3))) unsigned* cnt, unsigned& epoch, int lane) {
    epoch += 4u;
    if (lane == 0) (void)__hip_atomic_fetch_add(cnt, 1u, __ATOMIC_RELAXED, __HIP_MEMORY_SCOPE_WORKGROUP);
    unsigned spins = 0;
    while ((unsigned)__builtin_amdgcn_readfirstlane((int)__hip_atomic_load(cnt, __ATOMIC_RELAXED, __HIP_MEMORY_SCOPE_WORKGROUP)) < epoch) { __builtin_amdgcn_s_sleep(1); if (++spins > (1u << 22)) break; }
    asm volatile("" ::: "memory");
}
__device__ __forceinline__ void grp_bar(__attribute__((address_space(3))) unsigned* cnt, unsigned& epoch, int lane) {
    asm volatile("s_waitcnt vmcnt(0) lgkmcnt(0)" ::: "memory");
    grp_arrive_wait(cnt, epoch, lane);
}
__device__ __forceinline__ void grp_bar_counted(__attribute__((address_space(3))) unsigned* cnt, unsigned& epoch, int lane, int ntile) {
    if (ntile >= 4) asm volatile("s_waitcnt vmcnt(16) lgkmcnt(0)" ::: "memory");
    else if (ntile == 3) asm volatile("s_waitcnt vmcnt(12) lgkmcnt(0)" ::: "memory");
    else if (ntile == 2) asm volatile("s_waitcnt vmcnt(8) lgkmcnt(0)" ::: "memory");
    else if (ntile == 1) asm volatile("s_waitcnt vmcnt(4) lgkmcnt(0)" ::: "memory");
    else asm volatile("s_waitcnt vmcnt(0) lgkmcnt(0)" ::: "memory");
    grp_arrive_wait(cnt, epoch, lane);
}
__device__ __forceinline__ void attn_unit4(int b, int h, int qb16, int wid4, const unsigned short* Qb, const unsigned short* __restrict__ Kb, const unsigned short* __restrict__ Vb, unsigned short* AM, float bias2, char* shm,
                                           __attribute__((address_space(3))) unsigned* cnt, unsigned& epoch) {
    const int tid = tid_now(), lane = tid & 63, r32 = lane & 31, hi = lane >> 5;
    const unsigned short* Qw = Qb + (size_t)(b * TSEQ + qb16 * 128 + wid4 * 32) * DATT + h * HDIM;
    const unsigned short* Kh = Kb + (size_t)b * KPAD * DATT + h * HDIM; const unsigned short* Vh = Vb + (size_t)b * KPAD * DATT + h * HDIM;
    const unsigned lds0 = (unsigned)(uintptr_t)shm;
    const lds_cptr shm3 = (lds_cptr)shm;
    const unsigned short* ksrc0 = Kh + (size_t)lane * DATT + wid4 * 8; const unsigned short* ksrc1 = ksrc0 + 32;
    const unsigned short* vsrc0 = Vh + (size_t)(16 * wid4 + (lane >> 2)) * DATT + (lane & 3) * 8; const unsigned short* vsrc1 = vsrc0 + 32;
    const unsigned kdst = lds0 + LDS_K + wid4 * 1024, vdst = lds0 + LDS_V + wid4 * 1024;
#define SB_DMA(j, bo) do { const size_t to_ = (size_t)(j) * 64 * DATT; glds16(ksrc0 + to_, (unsigned)__builtin_amdgcn_readfirstlane(kdst + (bo))); glds16(ksrc1 + to_, (unsigned)__builtin_amdgcn_readfirstlane(kdst + (bo) + 4096)); \
        glds16(vsrc0 + to_, (unsigned)__builtin_amdgcn_readfirstlane(vdst + (bo))); glds16(vsrc1 + to_, (unsigned)__builtin_amdgcn_readfirstlane(vdst + (bo) + 4096)); } while (0)
    const int vb0 = (int)(lds0 + LDS_V) + ((lane >> 4) & 1) * 32 + (lane & 3) * 8 + (4 * hi + ((lane & 15) >> 2)) * 64;
    const lds_cptr kp0 = shm3 + LDS_K;
    const unsigned qdst = lds0 + LDS_Q + wid4 * 4096;
#pragma unroll
    for (int d0 = 0; d0 < 4; ++d0) glds16(Qw + (size_t)r32 * DATT + d0 * 16 + hi * 8, (unsigned)__builtin_amdgcn_readfirstlane(qdst + d0 * 1024));
    bf16x8 qr[4];
    f16x8 Ta, Tb, On;
#pragma unroll
    for (int jj = 0; jj < 8; ++jj) { const int key = (jj & 3) + 8 * (jj >> 2) + 4 * hi; Ta[jj] = key > r32 ? (_Float16)(-1.f) : (_Float16)0.f; Tb[jj] = (16 + key) > r32 ? (_Float16)(-1.f) : (_Float16)0.f; On[jj] = (_Float16)(-1.f); }
    f32x16 cb;
#pragma unroll
    for (int r = 0; r < 16; ++r) cb[r] = bias2;
    f32x16 o[2]; o[0] = f32x16{}; o[1] = f32x16{};
    float carry = 0.f;
    const int jmax = 2 * qb16 + 2, jd = 2 * qb16 + 1 + (wid4 >> 1);
    const int lim = 32 * (wid4 & 1) + r32;
    int slot = 0;
    { int sl = 0;
#pragma unroll 1
      for (int t = jmax; t > jmax - PD && t >= 0; --t) { SB_DMA(t, sl * SLOTB); ++sl; } }
    for (int j = jmax; j >= 0; --j) {
        grp_bar_counted(cnt, epoch, lane, j < PD - 1 ? j : PD - 1);
        if (j == jmax) {
#pragma unroll
            for (int d0 = 0; d0 < 4; ++d0) qr[d0] = *(const __attribute__((address_space(3))) bf16x8*)(shm3 + LDS_Q + wid4 * 4096 + d0 * 1024 + lane * 16);
        }
        if (j - PD >= 0) { const int ns = (slot == 0) ? NSLOT - 1 : slot - 1; SB_DMA(j - PD, ns * SLOTB); }
        const int buf = slot;
        if (j <= jd) {
            f32x16 p0, p1;
            qkt(p0, p1, kp0 + buf * SLOTB, qr, cb, r32, hi);
            if (j == jd) {
#pragma unroll
                for (int r = 0; r < 16; ++r) { const int kk = crow(r, hi); if (kk >= lim) p0[r] = -200.f; if (kk + 32 >= lim) p1[r] = -200.f; }
            }
            if (j == 0) {
#pragma unroll
                for (int r = 0; r < 16; ++r) { const int kk = crow(r, hi); p0[r] = -200.f; if (kk + 32 < 48) p1[r] = -200.f; }
            }
            f32x16 l0, l1;
#pragma unroll
            for (int r = 0; r < 16; ++r) { p0[r] = fminf(p0[r], 126.f); p1[r] = fminf(p1[r], 126.f);
                l0[r] = __builtin_amdgcn_logf(1.f + __builtin_amdgcn_exp2f(p0[r])); l1[r] = __builtin_amdgcn_logf(1.f + __builtin_amdgcn_exp2f(p1[r])); }
            const float z0 = p0[0];
            f32x16 s0, s1;
#pragma unroll
            for (int r = 0; r < 16; ++r) { s0[r] = (p0[r] - l0[r]) + carry; s1[r] = (p1[r] - l1[r]) + carry; }
            const f16x8 sl0 = l8(l0, 0), sl1 = l8(l0, 8), sl2 = l8(l1, 0), sl3 = l8(l1, 8);
            s0 = __builtin_amdgcn_mfma_f32_32x32x16_f16(Ta, sl0, s0, 0, 0, 0);
            s0 = __builtin_amdgcn_mfma_f32_32x32x16_f16(Tb, sl1, s0, 0, 0, 0);
            s0 = __builtin_amdgcn_mfma_f32_32x32x16_f16(On, sl2, s0, 0, 0, 0);
            s0 = __builtin_amdgcn_mfma_f32_32x32x16_f16(On, sl3, s0, 0, 0, 0);
            s1 = __builtin_amdgcn_mfma_f32_32x32x16_f16(Ta, sl2, s1, 0, 0, 0);
            s1 = __builtin_amdgcn_mfma_f32_32x32x16_f16(Tb, sl3, s1, 0, 0, 0);
            const float nc = s0[0] - z0;
            carry = __shfl(nc, r32);
#pragma unroll
            for (int r = 0; r < 16; ++r) { s0[r] = __builtin_amdgcn_exp2f(s0[r]); s1[r] = __builtin_amdgcn_exp2f(s1[r]); }
            u32x4 pw0 = (u32x4){cvtpk(s0[0], s0[1]), cvtpk(s0[2], s0[3]), cvtpk(s0[4], s0[5]), cvtpk(s0[6], s0[7])};
            u32x4 pw1 = (u32x4){cvtpk(s0[8], s0[9]), cvtpk(s0[10], s0[11]), cvtpk(s0[12], s0[13]), cvtpk(s0[14], s0[15])};
            u32x4 pw2 = (u32x4){cvtpk(s1[0], s1[1]), cvtpk(s1[2], s1[3]), cvtpk(s1[4], s1[5]), cvtpk(s1[6], s1[7])};
            u32x4 pw3 = (u32x4){cvtpk(s1[8], s1[9]), cvtpk(s1[10], s1[11]), cvtpk(s1[12], s1[13]), cvtpk(s1[14], s1[15])};
            pv(o, vb0 + buf * SLOTB, __builtin_bit_cast(bf16x8, pw0), __builtin_bit_cast(bf16x8, pw1), __builtin_bit_cast(bf16x8, pw2), __builtin_bit_cast(bf16x8, pw3));
        }
        slot = (slot == NSLOT - 1) ? 0 : slot + 1;
    }
#undef SB_DMA
    unsigned short* Ow = AM + (size_t)(b * TSEQ + qb16 * 128 + wid4 * 32) * D + h * HDIM;
    { __hip_bfloat16* stg = (__hip_bfloat16*)(shm + LDS_OST) + wid4 * 2048;
#pragma unroll
        for (int r = 0; r < 16; ++r) { const int orow = crow(r, hi);
#pragma unroll
            for (int d0 = 0; d0 < 2; ++d0) stg[orow * 64 + d0 * 32 + r32] = __float2bfloat16(o[d0][r]); }
        asm volatile("s_waitcnt lgkmcnt(0)" ::: "memory");
#pragma unroll
        for (int i = 0; i < 4; ++i) { const int row = i * 8 + (lane >> 3), ch = lane & 7; const u32x4 v = *(const u32x4*)(stg + row * 64 + ch * 8); *(u32x4*)(Ow + (size_t)row * D + ch * 8) = v; } }
    grp_bar(cnt, epoch, lane);
}
}

namespace sm {
typedef short bf16x8 __attribute__((ext_vector_type(8)));
typedef float f32x4 __attribute__((ext_vector_type(4)));
typedef unsigned u32x2 __attribute__((ext_vector_type(2)));
__device__ __forceinline__ u32x2 pack4(const f32x4 a) { u32x2 w; w.x = pg8::cvt_pk_bf16(a[0], a[1]); w.y = pg8::cvt_pk_bf16(a[2], a[3]); return w; }
__device__ __forceinline__ f32x4 unpack4(const u32x2 w) { return (f32x4){pg8::bf_lo(w.x), pg8::bf_hi(w.x), pg8::bf_lo(w.y), pg8::bf_hi(w.y)}; }
template <int NRT, bool MERGE, class EpiS>
__device__ __forceinline__ void small_job(__attribute__((address_space(3))) unsigned char* lds, const unsigned short* A, int K, const unsigned short* Bt, int colA0, int colB0, int row0, const EpiS& E) {
    const int tid = tid_now(), lane = tid & 63, fr = lane & 15, fq = lane >> 4, wid = __builtin_amdgcn_readfirstlane(tid >> 6);
    const int kw = K >> 3, kbase = wid * kw, steps = kw >> 5;
    f32x4 acc[NRT][2];
#pragma unroll
    for (int rt = 0; rt < NRT; ++rt) { acc[rt][0] = (f32x4){0.f, 0.f, 0.f, 0.f}; acc[rt][1] = (f32x4){0.f, 0.f, 0.f, 0.f}; }
    const unsigned short* ap = A + (size_t)fr * K + kbase + 8 * fq;
    const unsigned short* bpA = Bt + (size_t)(colA0 + fr) * K + kbase + 8 * fq;
    const unsigned short* bpB = Bt + (size_t)(colB0 + fr) * K + kbase + 8 * fq;
#pragma unroll 4
    for (int s = 0; s < steps; ++s) {
        const bf16x8 b0 = *(const bf16x8*)(bpA + s * 32), b1 = *(const bf16x8*)(bpB + s * 32);
        bf16x8 a[NRT];
#pragma unroll
        for (int rt = 0; rt < NRT; ++rt) a[rt] = *(const bf16x8*)(ap + (size_t)rt * 16 * K + s * 32);
#pragma unroll
        for (int rt = 0; rt < NRT; ++rt) { acc[rt][0] = __builtin_amdgcn_mfma_f32_16x16x32_bf16(b0, a[rt], acc[rt][0], 0, 0, 0); acc[rt][1] = __builtin_amdgcn_mfma_f32_16x16x32_bf16(b1, a[rt], acc[rt][1], 0, 0, 0); }
    }
    __attribute__((address_space(3))) f32x4* part = (__attribute__((address_space(3))) f32x4*)lds;
#pragma unroll
    for (int rt = 0; rt < NRT; ++rt) { part[((wid * NRT + rt) * 2 + 0) * 64 + lane] = acc[rt][0]; part[((wid * NRT + rt) * 2 + 1) * 64 + lane] = acc[rt][1]; }
    asm volatile("s_waitcnt lgkmcnt(0)" ::: "memory"); __syncthreads();
    if (tid < NRT * 64) {
        const int rt = tid >> 6;
        f32x4 va = (f32x4){0.f, 0.f, 0.f, 0.f}, vb = va, va2 = va, vb2 = va;
#pragma unroll
        for (int w = 0; w < 8; ++w) { const f32x4 pa = part[((w * NRT + rt) * 2 + 0) * 64 + lane], pb = part[((w * NRT + rt) * 2 + 1) * 64 + lane];
            if (MERGE && w >= 4) { va2 += pa; vb2 += pb; } else { va += pa; vb += pb; } }
        E(row0 + rt * 16 + fr, colA0 + 4 * fq, va, colB0 + 4 * fq, vb, va2, vb2);
    }
    __syncthreads();
}
__device__ __forceinline__ void job_cols(int j, bool paired, int& cA, int& cB) { if (paired) { cA = (j >> 3) * 256 + (j & 7) * 16; cB = cA + 128; } else { cA = j * 32; cB = cA + 16; } }

struct EpiS1 {
    unsigned short *Qb, *Kb, *Vb, *BG, *U, *G; float* out;
    __device__ __forceinline__ void kv(int row, int c, const f32x4 v) const {
        const bool isv = c >= 1024; unsigned short* KV = isv ? Vb : Kb; float* outp = out + (isv ? OFF_VP : OFF_KP); float* outs = out + (isv ? OFF_VS : OFF_KS); const int col = c - (isv ? 1024 : 512);
        if (row < ROW_SAMP) { const int i = row - ROW_META; const u32x2 w = pack4(v);
            for (int b = 0; b < NBATCH; ++b) { *(u32x2*)(KV + (size_t)(b * KPAD + 48 + i) * DATT + col) = w; *(f32x4*)(outp + (size_t)(b * LSEQ + i) * DATT + col) = v; } }
        else *(f32x4*)(outs + (size_t)(row - ROW_SAMP) * DATT + col) = v;
    }
    __device__ __forceinline__ void operator()(int row, int cA, const f32x4 va, int cB, const f32x4 vb, const f32x4, const f32x4) const {
        const int pn = cA >> 8;
        if (pn < 2) { *(u32x2*)(Qb + (size_t)row * DATT + cA) = pack4(va * C2); *(u32x2*)(Qb + (size_t)row * DATT + cB) = pack4(vb * C2); }
        else if (pn < 6) { kv(row, cA, va); kv(row, cB, vb); }
        else if (pn < 8) { *(u32x2*)(BG + (size_t)row * DCONV + (cA - 1536)) = pack4(va); *(u32x2*)(BG + (size_t)row * DCONV + (cB - 1536)) = pack4(vb); }
        else if (pn < 12) { const int ch = (pn - 8) * 128 + (cA & 127); const f32x4 u = va * vb; *(u32x2*)(U + (size_t)row * DCONV + ch) = pack4(u);
            if (row >= ROW_SAMP) *(f32x4*)(out + OFF_CS + (size_t)((row - ROW_SAMP) * 2 + 1) * DCONV + ch) = u; }
        else { const int ch = (pn - 12) * 128 + (cA & 127); f32x4 r, s;
#pragma unroll
            for (int e = 0; e < 4; ++e) { const float ga = fminf(fmaxf(va[e], -30.f), 30.f), gb = fminf(fmaxf(vb[e], -30.f), 30.f);
                const float ea = __builtin_amdgcn_exp2f(-ga * LOG2E), eb = __builtin_amdgcn_exp2f(-gb * LOG2E); r[e] = (1.f + eb) * __builtin_amdgcn_rcpf(1.f + ea); s[e] = __builtin_amdgcn_rcpf(1.f + eb); }
            *(u32x2*)(G + (size_t)row * 2048 + ch) = pack4(r); *(u32x2*)(G + (size_t)row * 2048 + 1024 + ch) = pack4(s); }
    }
};
struct EpiS3 {
    const unsigned short* G; unsigned short* Mb;
    __device__ __forceinline__ void one(int row, int c, const f32x4 ya, const f32x4 yb) const {
        const f32x4 r = unpack4(*(const u32x2*)(G + (size_t)row * 2048 + c)), s = unpack4(*(const u32x2*)(G + (size_t)row * 2048 + 1024 + c));
        *(u32x2*)(Mb + (size_t)row * D + c) = pack4((ya * r + yb) * s); }
    __device__ __forceinline__ void operator()(int row, int cA, const f32x4 va, int cB, const f32x4 vb, const f32x4 va2, const f32x4 vb2) const { one(row, cA, va, va2); one(row, cB, vb, vb2); }
};
struct EpiS4 {
    pg8::RowMap R; unsigned short* X1b; float* rowsum;
    __device__ __forceinline__ void operator()(int row, int cA, const f32x4 va, int cB, const f32x4 vb, const f32x4, const f32x4) const {
        const float* xi = R.xin(row); float* xo = R.x1(row);
        const f32x4 a = *(const f32x4*)(xi + cA) + va, b = *(const f32x4*)(xi + cB) + vb;
        *(f32x4*)(xo + cA) = a; *(f32x4*)(xo + cB) = b; *(u32x2*)(X1b + (size_t)row * D + cA) = pack4(a); *(u32x2*)(X1b + (size_t)row * D + cB) = pack4(b);
        unsafeAtomicAdd(rowsum + row, (a[0] * a[0] + a[1] * a[1]) + (a[2] * a[2] + a[3] * a[3]) + (b[0] * b[0] + b[1] * b[1]) + (b[2] * b[2] + b[3] * b[3]));
    }
};
struct EpiS5 {
    const float* rowsum; unsigned short* ACT;
    __device__ __forceinline__ void operator()(int row, int cA, const f32x4 va, int cB, const f32x4 vb, const f32x4, const f32x4) const {
        const float rstd = __builtin_amdgcn_rsqf(rowsum[row] * (1.0f / D) + EPS); f32x4 o;
#pragma unroll
        for (int e = 0; e < 4; ++e) { const float g = va[e] * rstd, up = vb[e] * rstd; o[e] = g * __builtin_amdgcn_rcpf(1.f + __builtin_amdgcn_exp2f(-g * LOG2E)) * up; }
        *(u32x2*)(ACT + (size_t)row * FF + (cA >> 8) * 128 + (cA & 127)) = pack4(o);
    }
};
struct EpiS6 {
    pg8::RowMap R; float* rowsum;
    __device__ __forceinline__ void operator()(int row, int cA, const f32x4 va, int cB, const f32x4 vb, const f32x4, const f32x4) const {
        float* xo = R.x1(row);
        const f32x4 a = *(const f32x4*)(xo + cA) + va, b = *(const f32x4*)(xo + cB) + vb;
        *(f32x4*)(xo + cA) = a; *(f32x4*)(xo + cB) = b;
        unsafeAtomicAdd(rowsum + row, (a[0] * a[0] + a[1] * a[1]) + (a[2] * a[2] + a[3] * a[3]) + (b[0] * b[0] + b[1] * b[1]) + (b[2] * b[2] + b[3] * b[3]));
    }
};
}

constexpr int NWAVES = 8;
constexpr int N_PHASES = 8;
#ifndef PROBE_DUP
#define PROBE_DUP -1
#endif
#ifndef MK_ONE_LAUNCH
#define MK_ONE_LAUNCH 1
#endif
constexpr size_t MiB = 1u << 20;
constexpr size_t WS_CTL = 0, CTL_ZERO_BYTES = 1 * MiB;
constexpr size_t WS_W1 = 2 * MiB, WS_WM = 12 * MiB, WS_WO = 14 * MiB, WS_WGU = 16 * MiB, WS_WD = 27 * MiB;
constexpr size_t WS_H = 33 * MiB, WS_AM = WS_H;
constexpr size_t WS_Q = 66 * MiB, WS_K = 83 * MiB, WS_MB = WS_Q;
constexpr size_t WS_V = 100 * MiB, WS_BG = 117 * MiB, WS_X1B = WS_V;
constexpr size_t WS_U = 134 * MiB, WS_G = 151 * MiB, WS_ACT = WS_U;
constexpr size_t WS_X1S = 225 * MiB, WS_END = 226 * MiB;
static_assert(WS_W1 + (size_t)NIN * D * 2 <= WS_WM && WS_WGU + (size_t)NGU * D * 2 <= WS_WD && WS_WD + (size_t)D * FF * 2 <= WS_H && WS_H + (size_t)M_TOT * D * 2 <= WS_Q && WS_Q + (size_t)M_TOT * DATT * 2 <= WS_K
              && WS_K + (size_t)NBATCH * KPAD * DATT * 2 <= WS_V && WS_V + (size_t)NBATCH * KPAD * DATT * 2 <= WS_BG && WS_BG + (size_t)M_TOT * DCONV * 2 <= WS_U && WS_U + (size_t)M_TOT * DCONV * 2 <= WS_G
              && WS_G + (size_t)M_TOT * 2048 * 2 <= WS_X1S && WS_MB + (size_t)M_TOT * D * 2 <= WS_V && WS_X1B + (size_t)M_TOT * D * 2 <= WS_U
              && WS_ACT + (size_t)M_TOT * FF * 2 <= WS_X1S && WS_X1S + (size_t)256 * D * 4 <= WS_END, "d_ws map");
constexpr int CW_BAR = 4096;
constexpr int CW_RS1 = 16384, CW_RS2 = 40960;
static_assert((CW_RS2 + M_TOT) * 4 <= (int)CTL_ZERO_BYTES, "CTL words inside the memset region");
constexpr int RING_OFF = 0, RING_BYTES = 131072;
constexpr int LDSCTL_OFF = RING_BYTES, MISC_OFF = LDSCTL_OFF + 320;
constexpr int LDS_BYTES = 147456;
static_assert(MISC_OFF + 128 <= LDS_BYTES, "LDS map");

#define GAS __attribute__((address_space(1)))
#define LAS __attribute__((address_space(3)))
typedef unsigned short bf16;
typedef unsigned v4u __attribute__((ext_vector_type(4)));
typedef float f32x4 __attribute__((ext_vector_type(4)));
typedef GAS unsigned gu32;
#define RLX_AGENT __ATOMIC_RELAXED, __HIP_MEMORY_SCOPE_AGENT
#define LDS_WAIT() asm volatile("s_waitcnt lgkmcnt(0)" ::: "memory")
#define VM_WAIT() asm volatile("s_waitcnt vmcnt(0)" ::: "memory")
__device__ __forceinline__ unsigned f2bf(float f) { unsigned u = __builtin_bit_cast(unsigned, f); return (u + 0x7fffu + ((u >> 16) & 1u)) >> 16; }
__device__ __forceinline__ unsigned pk2(float lo, float hi) { return f2bf(lo) | (f2bf(hi) << 16); }
__device__ __forceinline__ float bfl(unsigned w) { return __builtin_bit_cast(float, w << 16); }
__device__ __forceinline__ float bfh(unsigned w) { return __builtin_bit_cast(float, w & 0xffff0000u); }

#define XB_TMO      128
#define XB_XCNT(j)  (256  + 64 * (j))
#define XB_XSUB(j)  (1280 + 64 * (j))
#define XB_XGEN(j)  (2304 + 64 * (j))
#define XB_TOP      3328
#define XB_TOPGEN   3392
#define XCD_BAR_WORDS 3456
#define XB_SPIN_CAP (1u << 18)

__device__ __forceinline__ unsigned xb_ld(unsigned* p)              { return __hip_atomic_load(p, __ATOMIC_RELAXED, __HIP_MEMORY_SCOPE_AGENT); }
__device__ __forceinline__ unsigned xb_add(unsigned* p, unsigned v) { return __hip_atomic_fetch_add(p, v, __ATOMIC_RELAXED, __HIP_MEMORY_SCOPE_AGENT); }
__device__ __forceinline__ unsigned xb_xcc_id() { return (unsigned)__builtin_amdgcn_s_getreg((3 << 11) | 20) & 0xFu; }
#define XB_SPIN(cond, bar) do { unsigned _sp = 0; while (cond) { __builtin_amdgcn_s_sleep(1); \
    if ((++_sp & 255u) == 0u) { if (xb_ld(&(bar)[XB_TMO])) break; if (_sp > XB_SPIN_CAP) { atomicAdd(&(bar)[XB_TMO], 1u); break; } } } } while (0)

struct XcdBarrier {
    unsigned* bar; unsigned x;
    volatile LAS unsigned* st;
};

__device__ __forceinline__ XcdBarrier xcd_barrier_post(unsigned* bar, volatile LAS unsigned* st) {
    XcdBarrier b; b.bar = bar; b.x = xb_xcc_id(); b.st = st;
    if (threadIdx.x == 0) (void)xb_add(&bar[XB_XCNT(b.x)], 1u);
    return b;
}
__device__ __forceinline__ void xcd_barrier_complete(unsigned* bar, unsigned x, unsigned& nloc, unsigned& nx) {
    const unsigned G = gridDim.x * gridDim.y * gridDim.z;
    unsigned sum, cnt, mine, sp = 0u;
    for (;;) {
        sum = 0u; cnt = 0u; mine = 0u;
#pragma unroll
        for (unsigned j = 0; j < 16; ++j) { const unsigned c = xb_ld(&bar[XB_XCNT(j)]); sum += c; cnt += (c > 0u) ? 1u : 0u; mine = (j == x) ? c : mine; }
        if (sum == G) break;
        __builtin_amdgcn_s_sleep(1);
        if ((++sp & 255u) == 0u) { if (xb_ld(&bar[XB_TMO])) break; if (sp > XB_SPIN_CAP) { atomicAdd(&bar[XB_TMO], 1u); break; } }
    }
    nloc = mine > 0u ? mine : 1u; nx = cnt > 0u ? cnt : 1u;
}

__device__ __forceinline__ void xcd_barrier(const XcdBarrier& b) {
    asm volatile("s_waitcnt vmcnt(0)" ::: "memory");
    __syncthreads();
    if (threadIdx.x == 0) {
        unsigned* bar = b.bar;
        __builtin_amdgcn_s_waitcnt(0);
        unsigned nloc = b.st[0], nx = b.st[1];
        if (nloc == 0u) { xcd_barrier_complete(bar, b.x, nloc, nx); b.st[0] = nloc; b.st[1] = nx; }
        const unsigned old = xb_add(&bar[XB_XSUB(b.x)], 1u);
        const unsigned gen = old / nloc;
        if (old + 1u == (gen + 1u) * nloc) {
            __builtin_amdgcn_fence(__ATOMIC_RELEASE, "agent");
            asm volatile("s_waitcnt vmcnt(0)" ::: "memory");
            const unsigned og = xb_add(&bar[XB_TOP], 1u);
            const unsigned tg = og / nx;
            if (og + 1u == (tg + 1u) * nx) xb_add(&bar[XB_TOPGEN], 1u);
            else XB_SPIN(xb_ld(&bar[XB_TOPGEN]) == tg, bar);
            __builtin_amdgcn_fence(__ATOMIC_ACQUIRE, "agent");
            xb_add(&bar[XB_XGEN(b.x)], 1u);
            asm volatile("s_waitcnt vmcnt(0)" ::: "memory");
        } else {
            XB_SPIN(xb_ld(&bar[XB_XGEN(b.x)]) == gen, bar);
            __builtin_amdgcn_fence(__ATOMIC_ACQUIRE, "agent");
            asm volatile("s_waitcnt vmcnt(0)" ::: "memory");
        }
    }
    __syncthreads();
}

struct Frame {
    LAS unsigned char* lds;
    volatile LAS unsigned* MISC;
    gu32* ctl;
    int wave;
    int vcu, G;
};
__device__ __forceinline__ float wave_sum(float v) {
#pragma unroll
    for (int o = 1; o < 64; o <<= 1) v += __shfl_xor(v, o);
    return v;
}
__device__ __forceinline__ void tr_item(const float* W, int ldw, int scol0, int k0, bf16* WT, int drow0, int dpitch, int dk0, const float* kscale, LAS float* scr, int lane) {
#pragma unroll 8
    for (int i = 0; i < 32; ++i) { const int kk = 2 * i + (lane >> 5); float v = __builtin_nontemporal_load(W + (size_t)(k0 + kk) * ldw + scol0 + (lane & 31));     if (kscale) v *= kscale[k0 + kk]; scr[kk * 33 + (lane & 31)] = v; }
    LDS_WAIT(); asm volatile("" ::: "memory");
    const int c = lane & 7;
#pragma unroll
    for (int j = 0; j < 4; ++j) { const int n = (lane >> 3) + 8 * j; const LAS float* s = scr + (8 * c) * 33 + n;
        v4u o; o.x = pk2(s[0 * 33], s[1 * 33]); o.y = pk2(s[2 * 33], s[3 * 33]); o.z = pk2(s[4 * 33], s[5 * 33]); o.w = pk2(s[6 * 33], s[7 * 33]);
        *(GAS v4u*)(WT + (size_t)(drow0 + n) * dpitch + dk0 + k0 + 8 * c) = o; }
    LDS_WAIT(); asm volatile("" ::: "memory");
}
struct Args { const float* in[19]; float* out; unsigned char* ws; int ph_lo, ph_hi; };
static_assert(sizeof(Args) == 19 * 8 + 8 + 8 + 8, "Args has no padding");

__device__ __forceinline__ void p0_prologue(Frame& F, const Args& A, unsigned char* ws) {
    LAS float* scr = (LAS float*)(F.lds + RING_OFF + F.wave * 16384); const int lane = tid_now() & 63;
    const int gw = F.vcu * NWAVES + F.wave, NGW = F.G * NWAVES;
    const float* w_in = A.in[8]; const float* w_att_out = A.in[11]; const float* w_conv_out = A.in[12]; const float* w_o = A.in[13]; const float* norm_ffn = A.in[14];
    const float* w_gate = A.in[15]; const float* w_up = A.in[16]; const float* w_down = A.in[17];
    bf16* W1t = (bf16*)(ws + WS_W1); bf16* Wmt = (bf16*)(ws + WS_WM); bf16* Wot = (bf16*)(ws + WS_WO); bf16* Wgut = (bf16*)(ws + WS_WGU); bf16* Wdt = (bf16*)(ws + WS_WD);
    constexpr int I_1 = 16 * 160, I_MA = 8 * 32, I_MB = 8 * 32, I_O = 16 * 32, I_GU = 16 * 176, I_D = 44 * 32;
    constexpr int NITEMS = I_1 + I_MA + I_MB + I_O + I_GU + I_D;
    for (int it = gw; it < NITEMS; it += NGW) {
        int r = it;
        if (r < I_1) { const int kb = r / 160, nb = r % 160, n0 = nb * 32; int sc;
            if (n0 < 2048) sc = n0;
            else if (n0 < 3072) { const int i = (n0 - 2048) >> 8, w = (n0 - 2048) & 255; sc = w < 128 ? 2048 + 128 * i + w : 2560 + 128 * i + (w - 128); }
            else { const int i = (n0 - 3072) >> 8, w = (n0 - 3072) & 255; sc = w < 128 ? 3072 + 128 * i + w : 4096 + 128 * i + (w - 128); }
            tr_item(w_in, NIN, sc, kb * 64, W1t, n0, D, 0, nullptr, scr, lane); continue; } r -= I_1;
        if (r < I_MA) { const int kb = r / 32, nb = r % 32; tr_item(w_att_out, D, nb * 32, kb * 64, Wmt, nb * 32, D, 0, nullptr, scr, lane); continue; } r -= I_MA;
        if (r < I_MB) { const int kb = r / 32, nb = r % 32; tr_item(w_conv_out, D, nb * 32, kb * 64, Wmt, nb * 32, D, 512, nullptr, scr, lane); continue; } r -= I_MB;
        if (r < I_O) { const int kb = r / 32, nb = r % 32; tr_item(w_o, D, nb * 32, kb * 64, Wot, nb * 32, D, 0, nullptr, scr, lane); continue; } r -= I_O;
        if (r < I_GU) { const int kb = r / 176, nb = r % 176, n0 = nb * 32, i = n0 >> 8, w = n0 & 255;
            if (w < 128) tr_item(w_gate, FF, 128 * i + w, kb * 64, Wgut, n0, D, 0, norm_ffn, scr, lane);
            else tr_item(w_up, FF, 128 * i + (w - 128), kb * 64, Wgut, n0, D, 0, norm_ffn, scr, lane);
            continue; } r -= I_GU;
        { const int kb = r / 32, nb = r % 32; tr_item(w_down, D, nb * 32, kb * 64, Wdt, nb * 32, FF, 0, nullptr, scr, lane); }
    }
    const float* xp = A.in[0]; const float* xs = A.in[1]; const float* meta = A.in[6]; const float* gmix = A.in[7]; bf16* Hb = (bf16*)(ws + WS_H);
    f32x4 gv[4];
#pragma unroll
    for (int j = 0; j < 4; ++j) gv[j] = ((const GAS f32x4*)gmix)[lane + 64 * j];
    for (int m = gw; m < M_TOT; m += NGW) {
        GAS unsigned long long* o8 = (GAS unsigned long long*)(Hb + (size_t)m * D) + lane;
        if (m >= ROW_END) {
#pragma unroll
            for (int j = 0; j < 4; ++j) o8[64 * j] = 0ull;
            continue; }
        const float* xrow = m < MMAIN ? xp + (size_t)m * D : m < ROW_SAMP ? meta + (size_t)(m - ROW_META) * D : xs + (size_t)(m - ROW_SAMP) * D;
        const GAS f32x4* xr = (const GAS f32x4*)xrow + lane;
        f32x4 v[4]; float s2 = 0.f;
#pragma unroll
        for (int j = 0; j < 4; ++j) { v[j] = __builtin_nontemporal_load(xr + 64 * j); s2 += (v[j].x * v[j].x + v[j].y * v[j].y) + (v[j].z * v[j].z + v[j].w * v[j].w); }
        const float rstd = 1.f / sqrtf(wave_sum(s2) * (1.f / D) + EPS);
#pragma unroll
        for (int j = 0; j < 4; ++j) { const f32x4 y = v[j] * rstd * gv[j]; o8[64 * j] = (unsigned long long)pk2(y.x, y.y) | ((unsigned long long)pk2(y.z, y.w) << 32); }
    }
}

__device__ __forceinline__ void p2_conv(Frame& F, const Args& A, unsigned char* ws, int gw, int NGW) {
    const bf16* U = (const bf16*)(ws + WS_U); const bf16* BG = (const bf16*)(ws + WS_BG); bf16* AM = (bf16*)(ws + WS_AM);
    const float* convw = A.in[10]; const float* state = A.in[4];
    const int c8 = (tid_now() & 63) * 8;
    f32x4 w0a = *(const f32x4*)(convw + c8), w0b = *(const f32x4*)(convw + c8 + 4), w1a = *(const f32x4*)(convw + DCONV + c8), w1b = *(const f32x4*)(convw + DCONV + c8 + 4), w2a = *(const f32x4*)(convw + 2 * DCONV + c8), w2b = *(const f32x4*)(convw + 2 * DCONV + c8 + 4);
    for (int rr = gw; rr < MMAIN + NSAMP; rr += NGW) {
        f32x4 ua, ub, pa, pb, qa, qb; int row;
        if (rr < MMAIN) { row = rr; const int t = row & 2047;
            const int r1 = t >= 1 ? row - 1 : ROW_META + 15, r2 = t >= 2 ? row - 2 : ROW_META + 14 + t;
            pg8::unpack8(*(const v4u*)(U + (size_t)row * DCONV + c8), ua, ub); pg8::unpack8(*(const v4u*)(U + (size_t)r1 * DCONV + c8), pa, pb); pg8::unpack8(*(const v4u*)(U + (size_t)r2 * DCONV + c8), qa, qb);
        } else { const int s = rr - MMAIN; row = ROW_SAMP + s;
            pg8::unpack8(*(const v4u*)(U + (size_t)row * DCONV + c8), ua, ub);
            const float* s0 = state + (size_t)(s * 2 + 0) * DCONV + c8; const float* s1 = state + (size_t)(s * 2 + 1) * DCONV + c8;
            qa = *(const f32x4*)s0; qb = *(const f32x4*)(s0 + 4); pa = *(const f32x4*)s1; pb = *(const f32x4*)(s1 + 4);
            float* o = A.out + OFF_CS + (size_t)(s * 2 + 0) * DCONV + c8; *(f32x4*)o = pa; *(f32x4*)(o + 4) = pb; }
        f32x4 ga, gb; pg8::unpack8(*(const v4u*)(BG + (size_t)row * DCONV + c8), ga, gb);
        const f32x4 ya = ga * (w0a * qa + w1a * pa + w2a * ua), yb = gb * (w0b * qb + w1b * pb + w2b * ub);
        *(v4u*)(AM + (size_t)row * D + DATT + c8) = pg8::pack8(ya, yb);
    }
}

template <int CTRL, bool BC> __device__ __forceinline__ float dppf(float x) { return __builtin_bit_cast(float, __builtin_amdgcn_update_dpp(0, __builtin_bit_cast(int, x), CTRL, 0xF, 0xF, BC)); }
__device__ __forceinline__ float rdlane(float x, int l) { return __builtin_bit_cast(float, __builtin_amdgcn_readlane(__builtin_bit_cast(int, x), l)); }
__device__ __forceinline__ f32x4 ldnt(const float* p) { return __builtin_nontemporal_load((const f32x4*)p); }
__device__ __forceinline__ void p2_decode_unit4(const Args& A, unsigned char* ws, int s, int h, int dw, LAS float* part, LAS unsigned* cnt, unsigned& epoch) {
    const float* ck = A.in[2]; const float* cv = A.in[3]; const int* ptab = (const int*)A.in[5]; const float* sbb = A.in[9];
    const bf16* Qb = (const bf16*)(ws + WS_Q); bf16* AM = (bf16*)(ws + WS_AM);
    const int tid = tid_now(), lane = tid & 63, g = lane >> 4, j = lane & 15;
    const float bias2 = sbb[h] * LOG2E;
    f32x4 q4; { const unsigned long long qq = *(const unsigned long long*)(Qb + (size_t)(ROW_SAMP + s) * DATT + h * HDIM + 4 * j); q4 = (f32x4){bfl((unsigned)qq), bfh((unsigned)qq), bfl((unsigned)(qq >> 32)), bfh((unsigned)(qq >> 32))}; }
    f32x4 o4 = (f32x4){0.f, 0.f, 0.f, 0.f}; float carry = 0.f;
    const size_t loff = (size_t)(16 * g) * (NHEAD * HDIM) + h * HDIM + 4 * j;
    const int pvec = ptab[s * NPAGES + dw * 16 + (lane & 15)];
#define DEC_PAGE(k) ((size_t)__builtin_amdgcn_readlane(pvec, (k)))
    f32x4 kv[16], vv[16];
    { const size_t base = (DEC_PAGE(15) * PAGE + 64) * (NHEAD * HDIM) + loff;
#pragma unroll
      for (int i = 0; i < 16; ++i) kv[i] = ldnt(ck + base + (size_t)i * (NHEAD * HDIM)); }
    auto group = [&](const int gi, auto lastc) __attribute__((always_inline)) {
        const size_t base = (DEC_PAGE(15 - (gi >> 1)) * PAGE + (1 - (gi & 1)) * 64) * (NHEAD * HDIM) + loff;
#pragma unroll
        for (int i = 0; i < 16; ++i) vv[i] = ldnt(cv + base + (size_t)i * (NHEAD * HDIM));
        float zsel = 0.f;
#pragma unroll
        for (int i = 0; i < 16; ++i) { float p = (kv[i].x * q4.x + kv[i].y * q4.y) + (kv[i].z * q4.z + kv[i].w * q4.w);
            p += dppf<0x128, false>(p); p += dppf<0x124, false>(p); p += dppf<0x122, false>(p); p += dppf<0x121, false>(p);
            zsel = (j == i) ? p : zsel; }
        if constexpr (!decltype(lastc)::value) { const size_t nb = (DEC_PAGE(15 - ((gi + 1) >> 1)) * PAGE + (1 - ((gi + 1) & 1)) * 64) * (NHEAD * HDIM) + loff;
#pragma unroll
            for (int i = 0; i < 16; ++i) kv[i] = ldnt(ck + nb + (size_t)i * (NHEAD * HDIM)); }
        const float z2 = fminf(zsel + bias2, 126.f);
        const float lg = __builtin_amdgcn_logf(1.f + __builtin_amdgcn_exp2f(z2));
        float x = lg;
        x += dppf<0x101, true>(x); x += dppf<0x102, true>(x); x += dppf<0x104, true>(x); x += dppf<0x108, true>(x);
        const float t0 = rdlane(x, 0), t1 = rdlane(x, 16), t2 = rdlane(x, 32), t3 = rdlane(x, 48);
        x += (g == 0) ? (t1 + t2 + t3) : (g == 1) ? (t2 + t3) : (g == 2) ? t3 : 0.f;
        const float w = __builtin_amdgcn_exp2f((z2 - lg) - (x - lg) + carry);
        carry -= (t0 + t1) + (t2 + t3);
#define DEC_PV(i) { const float wb = dppf<0x150 + (i), false>(w); o4 += vv[i] * wb; }
        DEC_PV(0) DEC_PV(1) DEC_PV(2) DEC_PV(3) DEC_PV(4) DEC_PV(5) DEC_PV(6) DEC_PV(7) DEC_PV(8) DEC_PV(9) DEC_PV(10) DEC_PV(11) DEC_PV(12) DEC_PV(13) DEC_PV(14) DEC_PV(15)
#undef DEC_PV
    };
#pragma unroll 1
    for (int gi = 0; gi < 31; ++gi) group(gi, std::false_type{});
    group(31, std::true_type{});
#undef DEC_PAGE
#pragma unroll
    for (int e = 0; e < 4; ++e) { float t = o4[e]; t += __shfl_xor(t, 16); t += __shfl_xor(t, 32); o4[e] = t; }
    if (lane < 16) { *(LAS f32x4*)(part + dw * 68 + 4 * j) = o4; if (lane == 0) part[dw * 68 + 64] = carry; }
    sbattn::grp_bar(cnt, epoch, lane);
    if (dw == 0) { float acc = 0.f, cs = 0.f;
        for (int w = 3; w >= 0; --w) { acc += __builtin_amdgcn_exp2f(cs) * part[w * 68 + lane]; cs += part[w * 68 + 64]; }
        AM[(size_t)(ROW_SAMP + s) * D + h * HDIM + lane] = (bf16)f2bf(acc); }
    sbattn::grp_bar(cnt, epoch, lane);
}

__device__ __forceinline__ void p7_final(Frame& F, const Args& A, unsigned char* ws) {
    const float* gfin = A.in[18]; const float* rs2 = (const float*)(F.ctl + CW_RS2); const float* x1s = (const float*)(ws + WS_X1S); const bf16* X2b = (const bf16*)(ws + WS_MB);
    const int gw = F.vcu * NWAVES + F.wave, NGW = F.G * NWAVES, lane = tid_now() & 63;
    f32x4 gv[4];
#pragma unroll
    for (int j = 0; j < 4; ++j) gv[j] = ((const GAS f32x4*)gfin)[lane + 64 * j];
    f32x4 ga[2], gb[2];
#pragma unroll
    for (int j = 0; j < 2; ++j) { ga[j] = *(const f32x4*)(gfin + j * 512 + lane * 8); gb[j] = *(const f32x4*)(gfin + j * 512 + lane * 8 + 4); }
    for (int row = gw; row < MMAIN; row += NGW) {
        const float rstd = 1.f / sqrtf(rs2[row] * (1.f / D) + EPS);
#pragma unroll
        for (int j = 0; j < 2; ++j) { f32x4 a, b; pg8::unpack8(*(const v4u*)(X2b + (size_t)row * D + j * 512 + lane * 8), a, b);
            float* o = A.out + OFF_Y + (size_t)row * D + j * 512 + lane * 8; *(f32x4*)o = a * rstd * ga[j]; *(f32x4*)(o + 4) = b * rstd * gb[j]; }
    }
    for (int sidx = gw; sidx < NSAMP; sidx += NGW) {
        const int row = ROW_SAMP + sidx; const float* src = x1s + (size_t)(row - MMAIN) * D; float* dst = A.out + OFF_YS + (size_t)sidx * D;
        const float rstd = 1.f / sqrtf(rs2[row] * (1.f / D) + EPS);
#pragma unroll
        for (int j = 0; j < 4; ++j) { const f32x4 v = ((const GAS f32x4*)src)[lane + 64 * j]; ((GAS f32x4*)dst)[lane + 64 * j] = v * rstd * gv[j]; }
    }
}

__device__ __forceinline__ void p2_all(Frame& F, const Args& args, unsigned char* ws, unsigned char* lds, unsigned& epoch) {
    bf16* Qb = (bf16*)(ws + WS_Q); bf16* Kb = (bf16*)(ws + WS_K); bf16* Vb = (bf16*)(ws + WS_V); bf16* AM = (bf16*)(ws + WS_AM);
    const float* sbb = args.in[9];
    const int wid = F.wave;
    LAS unsigned* cntA = (LAS unsigned*)(F.lds + LDSCTL_OFF); LAS unsigned* cntD = cntA + 16;
    if (wid < 4) {
        for (int u = F.vcu; u < 256; u += F.G) {
            const int bh = u >> 2, qd = u & 3, b = bh >> 3, h = bh & 7; const float bias2 = sbb[h] * LOG2E;
#pragma unroll 1
            for (int kk = 0; kk < (PROBE_DUP == 2 ? 8 : 4); ++kk) { const int k = kk & 3; const int qb16 = (k == 0) ? 15 - qd : (k == 1) ? 11 - qd : (k == 2) ? 4 + qd : qd;
                sbattn::attn_unit4(b, h, qb16, wid, Qb, Kb, Vb, AM, bias2, (char*)lds + RING_OFF, cntA, epoch); }
        }
        p2_conv(F, args, ws, F.vcu * 4 + wid, F.G * 4);
    } else {
        for (int rep = 0; rep < (PROBE_DUP == 22 ? 2 : 1); ++rep) for (int u = (int)blockIdx.x; u < NSAMP * NHEAD; u += F.G) p2_decode_unit4(args, ws, u >> 3, u & 7, wid - 4, (LAS float*)(F.lds + LDSCTL_OFF + 1024), cntD, epoch);
    }
}

__global__ void __launch_bounds__(NWAVES * 64, 2) mk_fwd(Args args) {
    extern __shared__ __attribute__((aligned(16))) unsigned char lds[];
    Frame F;
    F.lds = (LAS unsigned char*)lds;
    F.MISC = (volatile LAS unsigned*)(F.lds + MISC_OFF);
    F.wave = __builtin_amdgcn_readfirstlane((int)threadIdx.x >> 6);
    F.G = gridDim.x; { const int bx = blockIdx.x; F.vcu = (F.G % 8 == 0) ? (bx % 8) * (F.G / 8) + bx / 8 : bx; }
    unsigned char* ws = args.ws;
    F.ctl = (gu32*)(ws + WS_CTL);
    for (int u = threadIdx.x; u < (LDS_BYTES - LDSCTL_OFF) / 4; u += NWAVES * 64) ((LAS unsigned*)(F.lds + LDSCTL_OFF))[u] = 0u;
    __syncthreads();
    const int lo = args.ph_lo, hi = args.ph_hi;
    const bool one = (hi - lo) > 1;
    XcdBarrier bar; bar.bar = (unsigned*)(F.ctl + CW_BAR); bar.x = 0; bar.st = nullptr;
    if (one) bar = xcd_barrier_post((unsigned*)(F.ctl + CW_BAR), F.MISC + 8);
#define IN(k) (lo <= (k) && (k) < hi)
#define BOTH(k) (IN(k) && IN((k) + 1))
#define GRID_BAR() xcd_barrier(bar)
    bf16* W1t = (bf16*)(ws + WS_W1); bf16* Wmt = (bf16*)(ws + WS_WM); bf16* Wot = (bf16*)(ws + WS_WO); bf16* Wgut = (bf16*)(ws + WS_WGU); bf16* Wdt = (bf16*)(ws + WS_WD);
    bf16* Hb = (bf16*)(ws + WS_H); bf16* Qb = (bf16*)(ws + WS_Q); bf16* Kb = (bf16*)(ws + WS_K); bf16* Vb = (bf16*)(ws + WS_V); bf16* BG = (bf16*)(ws + WS_BG); bf16* U = (bf16*)(ws + WS_U);
    bf16* G = (bf16*)(ws + WS_G); bf16* AM = (bf16*)(ws + WS_AM); bf16* Mb = (bf16*)(ws + WS_MB); bf16* X1b = (bf16*)(ws + WS_X1B); bf16* ACT = (bf16*)(ws + WS_ACT);
    float* rs1 = (float*)(F.ctl + CW_RS1); float* rs2 = (float*)(F.ctl + CW_RS2);
    pg8::RowMap RM{args.in[0], args.in[1], args.in[6], args.out + OFF_Y, (float*)(ws + WS_X1S)};

    if (IN(0)) { p0_prologue(F, args, ws); if (PROBE_DUP == 0) { GRID_BAR(); p0_prologue(F, args, ws); } if (BOTH(0)) GRID_BAR(); }
    if (IN(1)) {
        pg8::Gemm g{Hb, W1t, MMAIN, NIN, D}; pg8::StaticOrder S; S.init(MMAIN, NIN, F.G, (int)blockIdx.x);
        pg8::Epi1 E{Qb, Kb, Vb, BG, U, G, args.out};
        { const sm::EpiS1 ES{Qb, Kb, Vb, BG, U, G, args.out};
          for (int j = (int)blockIdx.x; j < 160; j += F.G) { int cA, cB; sm::job_cols(j, j >= 64, cA, cB); sm::small_job<3, false>(F.lds + RING_OFF, Hb + (size_t)MMAIN * D, D, W1t, cA, cB, MMAIN, ES); } }
        pg8::gemm_phase<pg8::Epi1, pg8::StaticOrder, true, true>(F.lds + RING_OFF, g, S, E);
        if (PROBE_DUP == 1) { GRID_BAR(); pg8::gemm_phase<pg8::Epi1, pg8::StaticOrder, true, true>(F.lds + RING_OFF, g, S, E); }
        if (BOTH(1)) GRID_BAR();
    }
    if (IN(2)) {
        unsigned p2_epoch = 0u; p2_all(F, args, ws, lds, p2_epoch);
        if (PROBE_DUP == 222) { GRID_BAR(); p2_all(F, args, ws, lds, p2_epoch); }
        if (BOTH(2)) GRID_BAR();
    }
    if (IN(3)) {
        pg8::Gemm g{AM, Wmt, MMAIN, D, D}; pg8::StaticOrder S; S.init(MMAIN, D, F.G, (int)blockIdx.x);
        pg8::Epi3 E{G, Mb};
        { const sm::EpiS3 ES{G, Mb};
          for (int j = (int)blockIdx.x; j < 32; j += F.G) { int cA, cB; sm::job_cols(j, false, cA, cB); sm::small_job<2, true>(F.lds + RING_OFF, AM + (size_t)ROW_SAMP * D, D, Wmt, cA, cB, ROW_SAMP, ES); } }
        pg8::gemm_phase<pg8::Epi3, pg8::StaticOrder, true, true>(F.lds + RING_OFF, g, S, E);
        if (PROBE_DUP == 3) { GRID_BAR(); pg8::gemm_phase<pg8::Epi3, pg8::StaticOrder, true, true>(F.lds + RING_OFF, g, S, E); }
        if (BOTH(3)) GRID_BAR();
    }
    if (IN(4)) {
        pg8::Gemm g{Mb, Wot, MMAIN, D, D}; pg8::StaticOrder S; S.init(MMAIN, D, F.G, (int)blockIdx.x);
        pg8::Epi4 E{RM, X1b, rs1};
        { const sm::EpiS4 ES{RM, X1b, rs1};
          for (int j = (int)blockIdx.x; j < 32; j += F.G) { int cA, cB; sm::job_cols(j, false, cA, cB); sm::small_job<2, false>(F.lds + RING_OFF, Mb + (size_t)ROW_SAMP * D, D, Wot, cA, cB, ROW_SAMP, ES); } }
        pg8::gemm_phase<pg8::Epi4, pg8::StaticOrder, true, true>(F.lds + RING_OFF, g, S, E);
        if (BOTH(4)) GRID_BAR();
    }
    if (IN(5)) {
        pg8::Gemm g{X1b, Wgut, MMAIN, NGU, D}; pg8::StaticOrder S; S.init(MMAIN, NGU, F.G, (int)blockIdx.x);
        pg8::Epi5 E{rs1, ACT};
        { const sm::EpiS5 ES{rs1, ACT};
          for (int j = (F.G == 256 ? ((int)blockIdx.x + 128) & 255 : (int)blockIdx.x); j < 176; j += (F.G == 256 ? 128 : F.G)) { if (F.G == 256 && (int)blockIdx.x < 128) break; int cA, cB; sm::job_cols(j, true, cA, cB);     sm::small_job<2, false>(F.lds + RING_OFF, X1b + (size_t)ROW_SAMP * D, D, Wgut, cA, cB, ROW_SAMP, ES); } }
        pg8::gemm_phase<pg8::Epi5, pg8::StaticOrder, true, true>(F.lds + RING_OFF, g, S, E);
        if (PROBE_DUP == 5) { GRID_BAR(); pg8::gemm_phase<pg8::Epi5, pg8::StaticOrder, true, true>(F.lds + RING_OFF, g, S, E); }
        if (BOTH(5)) GRID_BAR();
    }
    if (IN(6)) {
        pg8::Gemm g{ACT, Wdt, MMAIN, D, FF}; pg8::StaticOrder S; S.init(MMAIN, D, F.G, (int)blockIdx.x);
        pg8::Epi6 E{X1b, Mb, rs2};
        { const sm::EpiS6 ES{RM, rs2};
          for (int j = (int)blockIdx.x; j < 32; j += F.G) { int cA, cB; sm::job_cols(j, false, cA, cB); sm::small_job<2, false>(F.lds + RING_OFF, ACT + (size_t)ROW_SAMP * FF, FF, Wdt, cA, cB, ROW_SAMP, ES); } }
        pg8::gemm_phase<pg8::Epi6, pg8::StaticOrder, true, true>(F.lds + RING_OFF, g, S, E);
        if (BOTH(6)) GRID_BAR();
    }
    if (IN(7)) { p7_final(F, args, ws); }
#undef IN
#undef BOTH
#undef GRID_BAR
}

extern "C" void kernel_launch(void* const* d_in, const int* in_sizes, int n_in, void* d_out, int out_size, void* d_ws, size_t ws_size, hipStream_t stream) {
    static int grid = 0;
    if (grid == 0) {
        if (n_in != 19 || out_size != (int)OUT_TOTAL || ws_size < WS_END) { fprintf(stderr, "kernel_launch: unexpected shapes: n_in %d out %d ws %zu\n", n_in, out_size, ws_size); grid = -1; return; }
        int dev = 0, cus = 0, per_cu = 0;
        if (hipGetDevice(&dev) != hipSuccess || hipDeviceGetAttribute(&cus, hipDeviceAttributeMultiprocessorCount, dev) != hipSuccess) { grid = -1; return; }
        if (hipFuncSetAttribute((const void*)mk_fwd, hipFuncAttributeMaxDynamicSharedMemorySize, LDS_BYTES) != hipSuccess) { fprintf(stderr, "kernel_launch: hipFuncSetAttribute failed\n"); grid = -1; return; }
        if (hipOccupancyMaxActiveBlocksPerMultiprocessor(&per_cu, (const void*)mk_fwd, NWAVES * 64, LDS_BYTES) != hipSuccess || per_cu < 1) fprintf(stderr, "kernel_launch: occupancy query reports %d per CU\n", per_cu);
        (void)hipGetLastError();
        grid = cus;
    }
    if (grid < 0) return;
    if (hipMemsetAsync((char*)d_ws + WS_CTL, 0, CTL_ZERO_BYTES, stream) != hipSuccess) return;
    Args a{};
    for (int i = 0; i < 19; ++i) a.in[i] = (const float*)d_in[i];
    a.out = (float*)d_out; a.ws = (unsigned char*)d_ws;
#if MK_ONE_LAUNCH
    a.ph_lo = 0; a.ph_hi = N_PHASES;
    hipLaunchKernelGGL(mk_fwd, dim3(grid), dim3(NWAVES * 64), LDS_BYTES, stream, a);
#else
    for (int p = 0; p < N_PHASES; ++p) { a.ph_lo = p; a.ph_hi = p + 1; hipLaunchKernelGGL(mk_fwd, dim3(grid), dim3(NWAVES * 64), LDS_BYTES, stream, a); }
#endif
}
```
